# Optimizing an MI355X kernel written in HIP

```python
import math
import jax
import jax.numpy as jnp
from jax import lax
import numpy as np


D_MODEL = 1024
BATCH = 8
SEQ = 2048
DEPTH = 2

GRID_W = 64
CTX_LEN = 256
EPS = 1e-6
ROPE_BASE = 10000.0
ROPE_DIM = 64
Q_BLOCK = 128
MASK_VALUE = -1e30

A_HEADS = 4
A_QK = 64
A_V = 2 * A_QK
B_HEADS = 4
B_Q_LORA = 256
B_KV_LORA = 128
B_NOPE = 128
B_ROPE = 64
B_V = 128
C_HEADS = 4
C_DK = 128
C_DV = 128
C_CHUNK = 64
D_HEADS = 8
D_KV_HEADS = 2
D_HD = 64
WINDOW = 128
N_BRANCH = 4
BR_W = 512
PEER_HEADS = 8
N_KEYS = 128
N_EXPERTS = N_KEYS * N_KEYS
PEER_DK = 128
PEER_TOPK = 16
PEER_TOK_BLOCK = 128

IN_SIZES = (A_HEADS * A_QK, A_HEADS * A_QK, A_HEADS * A_QK, A_HEADS * A_QK, A_HEADS * A_V,
            B_Q_LORA, B_KV_LORA, B_ROPE,
            C_HEADS * C_DK, C_HEADS * C_DK, C_HEADS * C_DK, C_HEADS * C_DV, C_HEADS * C_DV,
            D_HEADS * D_HD, D_KV_HEADS * D_HD, D_KV_HEADS * D_HD,
            N_BRANCH * D_MODEL)
P_IN = sum(IN_SIZES)
CTX_KV_ONLY = (False, False, True, True, True, False, True, True, False, True, True, True, False, False, True, True, False)

kernel_name = 'hybrid_gated_mixers_peer_dit'


def rmsnorm(x, g):
    xf = x.astype(jnp.float32)
    y = xf * lax.rsqrt(jnp.mean(xf * xf, axis=-1, keepdims=True) + EPS)
    return (y * g.astype(jnp.float32)).astype(x.dtype)


def modulate(h, shift, scale):
    return h * (1.0 + scale) + shift


def project(h, w, keep):
    outs, off = [], 0
    if keep is None:
        p = h @ w
        for size in IN_SIZES:
            outs.append(p[..., off:off + size])
            off += size
    else:
        for size, k in zip(IN_SIZES, keep):
            outs.append(h @ w[:, off:off + size] if k else None)
            off += size
    return outs


def axial_angles(n, dim):
    rows = n // GRID_W
    r = jnp.repeat(jnp.arange(rows, dtype=jnp.float32), GRID_W)
    col = jnp.tile(jnp.arange(GRID_W, dtype=jnp.float32), rows)
    m = dim // 2
    freqs = ROPE_BASE ** (-2.0 * jnp.arange(m // 2, dtype=jnp.float32) / m)
    return jnp.concatenate([r[:, None] * freqs, col[:, None] * freqs], axis=-1)


def apply_rope(x, ang):
    B, n, H, dim = x.shape
    m = dim // 2
    xs = x.reshape(B, n, H, 2, 2, m // 2)
    a = ang.reshape(n, 1, 2, m // 2)
    cos = jnp.cos(a).astype(x.dtype)
    sin = jnp.sin(a).astype(x.dtype)
    x1, x2 = xs[..., 0, :], xs[..., 1, :]
    out = jnp.stack([x1 * cos - x2 * sin, x1 * sin + x2 * cos], axis=-2)
    return out.reshape(B, n, H, dim)


def over_query_blocks(f, *qs):
    B, n = qs[0].shape[:2]
    nb = n // Q_BLOCK
    split = lambda t: jnp.moveaxis(t.reshape((B, nb, Q_BLOCK) + t.shape[2:]), 1, 0)
    out = lax.map(lambda args: f(*args), tuple(split(t) for t in qs))
    return jnp.moveaxis(out, 0, 1).reshape((B, n) + out.shape[3:])


def attn_core(q, k, v, scale):
    p = jax.nn.softmax((jnp.einsum('bqhd,bkhd->bhqk', q, k) * scale).astype(jnp.float32), axis=-1)
    return jnp.einsum('bhqk,bkhd->bqhd', p.astype(v.dtype), v)


def diff_core(q1, q2, k1, k2, v, lam):
    scale = A_QK ** -0.5
    p1 = jax.nn.softmax((jnp.einsum('bqhd,bkhd->bhqk', q1, k1) * scale).astype(jnp.float32), axis=-1)
    p2 = jax.nn.softmax((jnp.einsum('bqhd,bkhd->bhqk', q2, k2) * scale).astype(jnp.float32), axis=-1)
    return jnp.einsum('bhqk,bkhd->bqhd', (p1 - lam * p2).astype(v.dtype), v)


def mixer_diff(px, pc, lq1, lk1, lq2, lk2, norm_g, layer, ang, ctx_out):
    heads = lambda t, d: t.reshape(t.shape[0], t.shape[1], A_HEADS, d)
    q1, q2, k1, k2 = [apply_rope(heads(t, A_QK), ang) for t in px[:4]]
    v = heads(px[4], A_V)
    k1c, k2c, vc = heads(pc[2], A_QK), heads(pc[3], A_QK), heads(pc[4], A_V)
    lam_init = 0.8 - 0.6 * math.exp(-0.3 * layer)
    f32 = jnp.float32
    lam = (jnp.exp(jnp.sum(lq1.astype(f32) * lk1.astype(f32)))
           - jnp.exp(jnp.sum(lq2.astype(f32) * lk2.astype(f32))) + lam_init)
    K1 = jnp.concatenate([k1, k1c], axis=1)
    K2 = jnp.concatenate([k2, k2c], axis=1)
    V = jnp.concatenate([v, vc], axis=1)
    ox = over_query_blocks(lambda a, b: diff_core(a, b, K1, K2, V, lam), q1, q2)
    post = lambda o: (rmsnorm(o, norm_g) * (1.0 - lam_init)).reshape(o.shape[0], o.shape[1], -1)
    oc = None
    if ctx_out:
        oc = post(diff_core(heads(pc[0], A_QK), heads(pc[1], A_QK), k1c, k2c, vc, lam))
    return post(ox), oc


def mixer_mla(px, pc, qn_g, kvn_g, w_uq, w_ukv, ang, ctx_out):
    def q_of(cq, rope):
        B, n = cq.shape[:2]
        q = (rmsnorm(cq, qn_g) @ w_uq).reshape(B, n, B_HEADS, B_NOPE + B_ROPE)
        q_rope = q[..., B_NOPE:]
        if rope:
            q_rope = apply_rope(q_rope, ang)
        return jnp.concatenate([q[..., :B_NOPE], q_rope], axis=-1)

    def kv_of(ckv, kr, rope):
        B, n = ckv.shape[:2]
        kv = (rmsnorm(ckv, kvn_g) @ w_ukv).reshape(B, n, B_HEADS, B_NOPE + B_V)
        k_rope = kr.reshape(B, n, 1, B_ROPE)
        if rope:
            k_rope = apply_rope(k_rope, ang)
        k = jnp.concatenate([kv[..., :B_NOPE], jnp.broadcast_to(k_rope, (B, n, B_HEADS, B_ROPE))], axis=-1)
        return k, kv[..., B_NOPE:]

    scale = (B_NOPE + B_ROPE) ** -0.5
    kx, vx = kv_of(px[1], px[2], True)
    kc, vc = kv_of(pc[1], pc[2], False)
    K = jnp.concatenate([kx, kc], axis=1)
    V = jnp.concatenate([vx, vc], axis=1)
    ox = over_query_blocks(lambda q: attn_core(q, K, V, scale), q_of(px[0], True))
    flat = lambda o: o.reshape(o.shape[0], o.shape[1], -1)
    oc = flat(attn_core(q_of(pc[0], False), kc, vc, scale)) if ctx_out else None
    return flat(ox), oc


def gla_scan(q, k, v, logf, s0):
    B, n, H, dk = q.shape
    nc = n // C_CHUNK
    chunks = lambda t: t.astype(jnp.float32).reshape(B, nc, C_CHUNK, H, t.shape[-1]).transpose(1, 0, 3, 2, 4)
    incl = jnp.tril(jnp.ones((C_CHUNK, C_CHUNK), dtype=bool))[:, :, None]

    def step(S, inp):
        qc, kc, vc, gc = inp
        b = jnp.cumsum(gc, axis=2)
        o_prev = jnp.einsum('bhtk,bhkv->bhtv', qc * jnp.exp(b), S)
        diff = b[:, :, :, None, :] - b[:, :, None, :, :]
        dec = jnp.where(incl, jnp.exp(jnp.where(incl, diff, 0.0)), 0.0)
        att = jnp.einsum('bhtk,bhsk,bhtsk->bhts', qc, kc, dec)
        o = o_prev + jnp.einsum('bhts,bhsv->bhtv', att, vc)
        b_end = b[:, :, -1:, :]
        S = (jnp.exp(b_end[:, :, 0, :])[..., None] * S
             + jnp.einsum('bhsk,bhsv->bhkv', kc * jnp.exp(b_end - b), vc))
        return S, o

    S, o = lax.scan(step, s0, (chunks(q), chunks(k), chunks(v), chunks(logf)))
    o = o.transpose(1, 0, 3, 2, 4).reshape(B, n, H, v.shape[-1])
    return o.astype(v.dtype), S


def gla_final_state(k, v, logf):
    b = jnp.cumsum(logf.astype(jnp.float32), axis=1)
    w = k.astype(jnp.float32) * jnp.exp(b[:, -1:] - b)
    return jnp.einsum('bnhk,bnhv->bhkv', w, v.astype(jnp.float32))


def mixer_hgrn(px, pc, lb_f, lb_b, norm_g, ctx_out):
    heads = lambda t, d: t.reshape(t.shape[0], t.shape[1], C_HEADS, d)
    flip = lambda t: jnp.flip(t, axis=1)

    def decay(z, lb):
        lbh = lb.astype(jnp.float32).reshape(C_HEADS, C_DK)
        f = lbh + (1.0 - lbh) * jax.nn.sigmoid(heads(z, C_DK).astype(jnp.float32))
        return jnp.log(f), 1.0 - f

    def readout(o, g):
        B, n = o.shape[:2]
        return (rmsnorm(o, norm_g) * jax.nn.silu(heads(g, C_DV))).reshape(B, n, C_HEADS * C_DV)

    B = px[0].shape[0]
    zeros = jnp.zeros((B, C_HEADS, C_DK, C_DV), jnp.float32)
    lf_cf, k_cf = decay(pc[1], lb_f)
    lf_cb, k_cb = decay(pc[2], lb_b)
    i_c = heads(pc[3], C_DV)
    oc = None
    if ctx_out:
        q_c = heads(pc[0], C_DK)
        o_cf, S_f = gla_scan(q_c, k_cf, i_c, lf_cf, zeros)
        o_cb, S_b = gla_scan(flip(q_c), flip(k_cb), flip(i_c), flip(lf_cb), zeros)
        oc = readout(o_cf + flip(o_cb), pc[4])
    else:
        S_f = gla_final_state(k_cf, i_c, lf_cf)
        S_b = gla_final_state(flip(k_cb), flip(i_c), flip(lf_cb))
    q_x = heads(px[0], C_DK)
    lf_xf, k_xf = decay(px[1], lb_f)
    lf_xb, k_xb = decay(px[2], lb_b)
    i_x = heads(px[3], C_DV)
    o_xf, _ = gla_scan(q_x, k_xf, i_x, lf_xf, S_f)
    o_xb, _ = gla_scan(flip(q_x), flip(k_xb), flip(i_x), flip(lf_xb), S_b)
    return readout(o_xf + flip(o_xb), px[4]), oc


def mixer_window(px, pc, sink, ang, ctx_out):
    B, n = px[0].shape[:2]
    G = D_HEADS // D_KV_HEADS
    nb = n // WINDOW
    scale = D_HD ** -0.5
    q = apply_rope(px[0].reshape(B, n, D_HEADS, D_HD), ang)
    k = apply_rope(px[1].reshape(B, n, D_KV_HEADS, D_HD), ang)
    v = px[2].reshape(B, n, D_KV_HEADS, D_HD)
    m = pc[1].shape[1]
    kc = pc[1].reshape(B, m, D_KV_HEADS, D_HD)
    vc = pc[2].reshape(B, m, D_KV_HEADS, D_HD)
    sink_b = sink.astype(jnp.float32).reshape(D_KV_HEADS, G)[:, :, None, None]
    L = 3 * WINDOW

    def band(t):
        tp = jnp.pad(t, ((0, 0), (WINDOW, WINDOW), (0, 0), (0, 0))).reshape(B, nb + 2, WINDOW, D_KV_HEADS, D_HD)
        return jnp.concatenate([tp[:, :-2], tp[:, 1:-1], tp[:, 2:]], axis=2)

    j = jnp.arange(L)
    a = jnp.arange(WINDOW)
    rel = j[None, :] - WINDOW - a[:, None]

    def block(args):
        qi, ki, vi, i = args
        kpos = i * WINDOW + j - WINDOW
        valid = (jnp.abs(rel) <= WINDOW) & ((kpos >= 0) & (kpos < n))[None, :]
        s_loc = jnp.where(valid, (jnp.einsum('bqkgd,bjkd->bkgqj', qi, ki) * scale).astype(jnp.float32), MASK_VALUE)
        s_ctx = (jnp.einsum('bqkgd,bckd->bkgqc', qi, kc) * scale).astype(jnp.float32)
        s_sink = jnp.broadcast_to(sink_b, s_ctx.shape[:-1] + (1,))
        p = jax.nn.softmax(jnp.concatenate([s_loc, s_ctx, s_sink], axis=-1), axis=-1).astype(vi.dtype)
        return (jnp.einsum('bkgqj,bjkd->bqkgd', p[..., :L], vi)
                + jnp.einsum('bkgqc,bckd->bqkgd', p[..., L:L + m], vc))

    qb = jnp.moveaxis(q.reshape(B, nb, WINDOW, D_KV_HEADS, G, D_HD), 1, 0)
    o = lax.map(block, (qb, jnp.moveaxis(band(k), 1, 0), jnp.moveaxis(band(v), 1, 0), jnp.arange(nb)))
    ox = jnp.moveaxis(o, 0, 1).reshape(B, n, D_HEADS * D_HD)
    oc = None
    if ctx_out:
        qc = pc[0].reshape(B, m, D_KV_HEADS, G, D_HD)
        s = (jnp.einsum('bqkgd,bckd->bkgqc', qc, kc) * scale).astype(jnp.float32)
        s_sink = jnp.broadcast_to(sink_b, s.shape[:-1] + (1,))
        p = jax.nn.softmax(jnp.concatenate([s, s_sink], axis=-1), axis=-1)[..., :m].astype(vc.dtype)
        oc = jnp.einsum('bkgqc,bckd->bqkgd', p, vc).reshape(B, m, D_HEADS * D_HD)
    return ox, oc


def merge_branches(outs, gate_logits, w_branch, w_out):
    gl = gate_logits.reshape(gate_logits.shape[:-1] + (N_BRANCH, D_MODEL))
    y = None
    for j in range(N_BRANCH):
        term = jax.nn.sigmoid(gl[..., j, :]) * (outs[j] @ w_branch[j])
        y = term if y is None else y + term
    return y @ w_out


def peer_ffn(h, wq, keys, u, v):
    B, n, D = h.shape
    hd = PEER_DK // 2
    KK = PEER_TOPK * PEER_TOPK

    def block(t):
        tb = t.shape[0]
        q = (t @ wq).reshape(tb, PEER_HEADS, 2, hd)
        s = jnp.einsum('thpd,hpkd->thpk', q, keys).astype(jnp.float32)
        sv, si = lax.top_k(s, PEER_TOPK)
        cand_s = (sv[:, :, 0, :, None] + sv[:, :, 1, None, :]).reshape(tb, PEER_HEADS, KK)
        cand_i = (si[:, :, 0, :, None] * N_KEYS + si[:, :, 1, None, :]).reshape(tb, PEER_HEADS, KK)
        top_s, pos = lax.top_k(cand_s, PEER_TOPK)
        idx = jnp.take_along_axis(cand_i, pos, axis=-1)
        g = jax.nn.softmax(top_s, axis=-1)
        act = jax.nn.gelu(jnp.einsum('td,thkd->thk', t, u[idx]).astype(jnp.float32), approximate=False)
        return jnp.einsum('thk,thkd->td', (g * act).astype(t.dtype), v[idx])

    out = lax.map(block, h.reshape((B * n) // PEER_TOK_BLOCK, PEER_TOK_BLOCK, D))
    return out.reshape(B, n, D)


def setup_inputs(seed: int = 0) -> dict:
    key = jax.random.key(seed)
    ks = iter(jax.random.split(key, 40))
    nrm = lambda shape, scale=1.0: jax.random.normal(next(ks), shape, jnp.float32) * scale
    gain = lambda shape: 1.0 + nrm(shape, 0.02)
    L, D = DEPTH, D_MODEL
    return {
        'x': nrm((BATCH, SEQ, D)),
        'c': nrm((BATCH, D)),
        'ctx': nrm((BATCH, CTX_LEN, D)),
        'c_ctx': nrm((D,)),
        'w_mod': nrm((L, D, 6 * D), 0.5 * D ** -0.5),
        'b_mod': nrm((L, 6 * D), 0.01),
        'norm1_g': gain((L, D)),
        'norm2_g': gain((L, D)),
        'w_in': nrm((L, D, P_IN), D ** -0.5),
        'diff_lam_q1': nrm((L, A_QK), 0.1),
        'diff_lam_k1': nrm((L, A_QK), 0.1),
        'diff_lam_q2': nrm((L, A_QK), 0.1),
        'diff_lam_k2': nrm((L, A_QK), 0.1),
        'diff_norm_g': gain((L, A_V)),
        'mla_qnorm_g': gain((L, B_Q_LORA)),
        'mla_kvnorm_g': gain((L, B_KV_LORA)),
        'mla_w_uq': nrm((L, B_Q_LORA, B_HEADS * (B_NOPE + B_ROPE)), B_Q_LORA ** -0.5),
        'mla_w_ukv': nrm((L, B_KV_LORA, B_HEADS * (B_NOPE + B_V)), B_KV_LORA ** -0.5),
        'hgrn_lb': nrm((2, L, C_HEADS * C_DK), 0.5),
        'hgrn_norm_g': gain((L, C_DV)),
        'win_sink': nrm((L, D_HEADS), 0.5),
        'w_branch': nrm((L, N_BRANCH, BR_W, D), BR_W ** -0.5),
        'w_out': nrm((L, D, D), D ** -0.5),
        'peer_wq': nrm((L, D, PEER_HEADS * PEER_DK), D ** -0.5),
        'peer_keys': nrm((L, PEER_HEADS, 2, N_KEYS, PEER_DK // 2), (PEER_DK // 2) ** -0.5),
        'peer_u': nrm((L, N_EXPERTS, D), D ** -0.5),
        'peer_v': nrm((L, N_EXPERTS, D), 0.5),
        'final_g': gain((D,)),
    }


def reference(x, c, ctx, c_ctx, w_mod, b_mod, norm1_g, norm2_g, w_in, diff_lam_q1, diff_lam_k1,
              diff_lam_q2, diff_lam_k2, diff_norm_g, mla_qnorm_g, mla_kvnorm_g, mla_w_uq, mla_w_ukv,
              hgrn_lb, hgrn_norm_g, win_sink, w_branch, w_out, peer_wq, peer_keys, peer_u, peer_v, final_g):
    n = x.shape[1]
    ang = axial_angles(n, ROPE_DIM)
    lb_p = jax.nn.softmax(hgrn_lb.astype(jnp.float32), axis=1)
    lb = jnp.cumsum(lb_p, axis=1) - lb_p[:, :1]
    s_c = jax.nn.silu(c)
    s_cc = jax.nn.silu(c_ctx)
    xc = ctx
    for l in range(DEPTH):
        last = l == DEPTH - 1
        ctx_out = not last
        mod = s_c @ w_mod[l] + b_mod[l]
        sh1, sc1, g1, sh2, sc2, g2 = [t[:, None, :] for t in jnp.split(mod, 6, axis=-1)]
        n_cm = 2 if last else 6
        mod_c = jnp.split(s_cc @ w_mod[l][:, :n_cm * D_MODEL] + b_mod[l][:n_cm * D_MODEL], n_cm, axis=-1)

        hx = modulate(rmsnorm(x, norm1_g[l]), sh1, sc1)
        hc = modulate(rmsnorm(xc, norm1_g[l]), mod_c[0], mod_c[1])
        px = project(hx, w_in[l], None)
        pc = project(hc, w_in[l], CTX_KV_ONLY if last else None)
        oa = mixer_diff(px[0:5], pc[0:5], diff_lam_q1[l], diff_lam_k1[l], diff_lam_q2[l], diff_lam_k2[l],
                        diff_norm_g[l], l, ang, ctx_out)
        ob = mixer_mla(px[5:8], pc[5:8], mla_qnorm_g[l], mla_kvnorm_g[l], mla_w_uq[l], mla_w_ukv[l], ang, ctx_out)
        oh = mixer_hgrn(px[8:13], pc[8:13], lb[0, l], lb[1, l], hgrn_norm_g[l], ctx_out)
        od = mixer_window(px[13:16], pc[13:16], win_sink[l], ang, ctx_out)
        branches = (oa, ob, oh, od)
        x = x + g1 * merge_branches([o[0] for o in branches], px[16], w_branch[l], w_out[l])
        if ctx_out:
            xc = xc + mod_c[2] * merge_branches([o[1] for o in branches], pc[16], w_branch[l], w_out[l])

        x = x + g2 * peer_ffn(modulate(rmsnorm(x, norm2_g[l]), sh2, sc2),
                              peer_wq[l], peer_keys[l], peer_u[l], peer_v[l])
        if ctx_out:
            xc = xc + mod_c[5] * peer_ffn(modulate(rmsnorm(xc, norm2_g[l]), mod_c[3], mod_c[4]),
                                          peer_wq[l], peer_keys[l], peer_u[l], peer_v[l])
    return rmsnorm(x, final_g)
```

```cpp
#include <hip/hip_runtime.h>
#include <stdint.h>
#include <stdio.h>

#ifndef MEGA
#define MEGA 1
#endif

typedef unsigned short bf16_t;
typedef short bf16x8 __attribute__((ext_vector_type(8)));
typedef float f32x4 __attribute__((ext_vector_type(4)));
typedef unsigned u32x4 __attribute__((ext_vector_type(4)));
typedef unsigned u32x2 __attribute__((ext_vector_type(2)));
typedef __bf16 bf16x2_t __attribute__((ext_vector_type(2)));

#define NB 8
#define SEQ 2048
#define CTXL 256
#define TU 2304
#define RR (NB * TU)
#define DM 1024
#define PW 3072
#define NTHREADS 256
#define LOG2E 1.4426950408889634f

#define PC_AQ 0
#define PC_AK1 512
#define PC_AK2 768
#define PC_CQ 1024
#define PC_CKV 1280
#define PC_HOH 1408
#define PC_HG 1920
#define PC_DQ 2432
#define PC_DK 2944

#define OFF_BAR   ((size_t)0)
#define OFF_MODP  ((size_t)16384)
#define OFF_MOD   (OFF_MODP + (size_t)2 * 8 * 9 * 6144 * 4)
#define OFF_ROPE  (OFF_MOD + (size_t)2 * 9 * 6144 * 4)
#define OFF_LB    (OFF_ROPE + (size_t)2048 * 32 * 8)
#define OFF_LAM   (OFF_LB + (size_t)2 * 2 * 512 * 4)
#define OFF_X     (OFF_LAM + (size_t)256)
#define OFF_HX    (OFF_X + (size_t)RR * DM * 4)
#define OFF_WIN   (OFF_HX + (size_t)RR * DM * 2)
#define OFF_WV    (OFF_WIN + (size_t)2688 * 1024 * 2)
#define OFF_WG    (OFF_WV + (size_t)2688 * 1024 * 2)
#define OFF_WUQ   (OFF_WG + (size_t)4096 * 1024 * 2)
#define OFF_WUK   (OFF_WUQ + (size_t)768 * 256 * 2)
#define OFF_WUV   (OFF_WUK + (size_t)512 * 128 * 2)
#define OFF_WBR   (OFF_WUV + (size_t)512 * 128 * 2)
#define OFF_WOUT  (OFF_WBR + (size_t)4 * 1024 * 512 * 2)
#define OFF_WPQ   (OFF_WOUT + (size_t)1024 * 1024 * 2)
#define OFF_KEYS  (OFF_WPQ + (size_t)1024 * 1024 * 2)
#define OFF_P     (OFF_KEYS + (size_t)8 * 2 * 128 * 64 * 2)
#define OFF_QB    (OFF_P + (size_t)RR * PW * 2)
#define OFF_KB    (OFF_QB + (size_t)RR * 768 * 2)
#define OFF_VTB   (OFF_KB + (size_t)RR * 768 * 2)
#define OFF_VTA   (OFF_VTB + (size_t)NB * 4 * 128 * TU * 2)
#define OFF_VTD   (OFF_VTA + (size_t)NB * 4 * 128 * TU * 2)
#define OFF_OA12  (OFF_VTD + (size_t)NB * 2 * 64 * TU * 2)
#define OFF_OB    (OFF_OA12 + (size_t)RR * 1024 * 2)
#define OFF_OHB   (OFF_OB + (size_t)RR * 512 * 2)
#define OFF_HT    (OFF_OHB + (size_t)RR * 512 * 2)
#define OFF_END   (OFF_HT + (size_t)NB * 4 * 4 * 128 * TU * 2)
#define OFF_Y     OFF_OA12
#define OFF_PQ    OFF_QB
#define OFF_TU    OFF_END
#define OFF_TV    (OFF_END + (size_t)16384 * 768)
#define OFF_SU    (OFF_END + (size_t)2 * 16384 * 768)
#define OFF_SV    (OFF_SU + 65536)
#define OFF_KEYS2 (OFF_SV + 65536)
#define KEYS_OFF(l) (((l) & 1) ? OFF_KEYS2 : OFF_KEYS)
#define OFF_TOP   (OFF_KEYS2 + (size_t)8 * 2 * 128 * 64 * 2)

typedef __attribute__((address_space(1))) char gchar;
struct Params {
    const float* in[28];
    float* out;
    gchar* ws;
};
struct DP : Params { int bid; int nblk; };

enum { I_X = 0, I_C, I_CTX, I_CCTX, I_WMOD, I_BMOD, I_N1G, I_N2G, I_WIN, I_LQ1, I_LK1, I_LQ2, I_LK2, I_DNG, I_QNG, I_KVNG, I_WUQ, I_WUKV,
       I_HLB, I_HNG, I_SINK, I_WBR, I_WOUT, I_PWQ, I_PKEYS, I_PU, I_PV, I_FG };

__device__ __forceinline__ unsigned f2bf(float f) { return (unsigned)__builtin_bit_cast(unsigned short, (__bf16)f); }
__device__ __forceinline__ float bflo(unsigned w) { return __uint_as_float(w << 16); }
__device__ __forceinline__ float bfhi(unsigned w) { return __uint_as_float(w & 0xffff0000u); }
__device__ __forceinline__ unsigned pack2(float a, float b) { bf16x2_t v = {(__bf16)a, (__bf16)b}; return __builtin_bit_cast(unsigned, v); }
__device__ __forceinline__ float wave_sum(float v) {
#pragma unroll
    for (int o = 32; o >= 1; o >>= 1) v += __shfl_xor(v, o);
    return v;
}
typedef unsigned v2u_t __attribute__((ext_vector_type(2)));
__device__ __forceinline__ float fmax_raw(float a, float b) { float r; asm("v_max_f32 %0, %1, %2" : "=v"(r) : "v"(a), "v"(b)); return r; }
__device__ __forceinline__ float rows_max(float v) {
    const v2u_t a = __builtin_amdgcn_permlane16_swap(__float_as_uint(v), __float_as_uint(v), false, false);
    v = fmax_raw(__uint_as_float(a.x), __uint_as_float(a.y));
    const v2u_t b = __builtin_amdgcn_permlane32_swap(__float_as_uint(v), __float_as_uint(v), false, false);
    return fmax_raw(__uint_as_float(b.x), __uint_as_float(b.y));
}
__device__ __forceinline__ float rows_sum(float v) {
    const v2u_t a = __builtin_amdgcn_permlane16_swap(__float_as_uint(v), __float_as_uint(v), false, false);
    v = __uint_as_float(a.x) + __uint_as_float(a.y);
    const v2u_t b = __builtin_amdgcn_permlane32_swap(__float_as_uint(v), __float_as_uint(v), false, false);
    return __uint_as_float(b.x) + __uint_as_float(b.y);
}
__device__ __forceinline__ float sigmoidf_(float x) { return 1.0f / (1.0f + __expf(-x)); }
__device__ __forceinline__ float siluf_(float x) { return x / (1.0f + __expf(-x)); }
__device__ __forceinline__ float dot2bf(unsigned a, unsigned b, float acc) {
    return __builtin_amdgcn_fdot2_f32_bf16(__builtin_bit_cast(bf16x2_t, a), __builtin_bit_cast(bf16x2_t, b), acc, false);
}

#define XB_TMO      128
#define XB_XCNT(j)  (256  + 64 * (j))
#define XB_XSUB(j)  (1280 + 64 * (j))
#define XB_XGEN(j)  (2304 + 64 * (j))
#define XB_TOP      3328
#define XB_TOPGEN   3392
#define XCD_BAR_WORDS 3456
#define XB_SPIN_CAP (1u << 22)
#define LAS __attribute__((address_space(3)))

__device__ __forceinline__ unsigned xb_ld(unsigned* p)              { return __hip_atomic_load(p, __ATOMIC_RELAXED, __HIP_MEMORY_SCOPE_AGENT); }
__device__ __forceinline__ unsigned xb_add(unsigned* p, unsigned v) { return __hip_atomic_fetch_add(p, v, __ATOMIC_RELAXED, __HIP_MEMORY_SCOPE_AGENT); }
__device__ __forceinline__ unsigned xb_xcc_id() { return (unsigned)__builtin_amdgcn_s_getreg((3 << 11) | 20) & 0xFu; }
#define XB_SPIN(cond, bar) do { unsigned _sp = 0; while (cond) { __builtin_amdgcn_s_sleep(1); \
    if ((++_sp & 255u) == 0u) { if (xb_ld(&(bar)[XB_TMO])) break; if (_sp > XB_SPIN_CAP) { atomicAdd(&(bar)[XB_TMO], 1u); break; } } } } while (0)

__device__ __forceinline__ void xcd_barrier_post(unsigned* bar) {
    if (threadIdx.x == 0) (void)xb_add(&bar[XB_XCNT(xb_xcc_id())], 1u);
}
__device__ __forceinline__ void xcd_barrier_complete(unsigned* bar, unsigned x, unsigned& nloc, unsigned& nx) {
    const unsigned G = gridDim.x;
    unsigned sum, cnt, mine, sp = 0u;
    for (;;) {
        sum = 0u; cnt = 0u; mine = 0u;
#pragma unroll 1
        for (unsigned j = 0; j < 16; ++j) { const unsigned c = xb_ld(&bar[XB_XCNT(j)]); sum += c; cnt += (c > 0u) ? 1u : 0u; mine = (j == x) ? c : mine; }
        if (sum == G) break;
        __builtin_amdgcn_s_sleep(1);
        if ((++sp & 255u) == 0u) { if (xb_ld(&bar[XB_TMO])) break; if (sp > XB_SPIN_CAP) { atomicAdd(&bar[XB_TMO], 1u); break; } }
    }
    nloc = mine > 0u ? mine : 1u; nx = cnt > 0u ? cnt : 1u;
}
__device__ __forceinline__ void xcd_barrier(unsigned* bar, volatile unsigned* st) {
    asm volatile("s_waitcnt vmcnt(0)" ::: "memory");
    __syncthreads();
    if (threadIdx.x == 0) {
        const unsigned x = xb_xcc_id();
        __builtin_amdgcn_s_waitcnt(0);
        unsigned nloc = st[0], nx = st[1];
        if (nloc == 0u) { xcd_barrier_complete(bar, x, nloc, nx); st[0] = nloc; st[1] = nx; }
        const unsigned old = xb_add(&bar[XB_XSUB(x)], 1u);
        const unsigned gen = old / nloc;
        if (old + 1u == (gen + 1u) * nloc) {
            __builtin_amdgcn_fence(__ATOMIC_RELEASE, "agent");
            asm volatile("s_waitcnt vmcnt(0)" ::: "memory");
            const unsigned og = xb_add(&bar[XB_TOP], 1u);
            const unsigned tg = og / nx;
            if (og + 1u == (tg + 1u) * nx) xb_add(&bar[XB_TOPGEN], 1u);
            else XB_SPIN(xb_ld(&bar[XB_TOPGEN]) == tg, bar);
            __builtin_amdgcn_fence(__ATOMIC_ACQUIRE, "agent");
            xb_add(&bar[XB_XGEN(x)], 1u);
            asm volatile("s_waitcnt vmcnt(0)" ::: "memory");
        } else {
            XB_SPIN(xb_ld(&bar[XB_XGEN(x)]) == gen, bar);
            __builtin_amdgcn_fence(__ATOMIC_ACQUIRE, "agent");
            asm volatile("s_waitcnt vmcnt(0)" ::: "memory");
        }
    }
    __syncthreads();
}

#define LDS_BYTES 74752
#define LDS_MISC  73728

__device__ __forceinline__ void phase_p0(const DP& p, char* lds, int tid) {
    float* modp = (float*)(p.ws + OFF_MODP);
    float* sl = (float*)lds;
    const int nitems = 2 * 8 * 24;
    for (int it = p.bid; it < nitems; it += p.nblk) {
        const int l = it / 192, rem = it % 192, ks = rem / 24, cb = rem % 24;
        const int k0 = ks * 128;
        __syncthreads();
        for (int e = tid; e < 9 * 128; e += NTHREADS) {
            const int r = e >> 7, k = e & 127;
            const float cv = (r < 8) ? p.in[I_C][r * DM + k0 + k] : p.in[I_CCTX][k0 + k];
            sl[e] = siluf_(cv);
        }
        __syncthreads();
        const int col = cb * 256 + tid;
        const float* w = p.in[I_WMOD] + (size_t)l * DM * 6144 + (size_t)k0 * 6144 + col;
        float acc[9];
#pragma unroll
        for (int r = 0; r < 9; ++r) acc[r] = 0.f;
        for (int k = 0; k < 128; ++k) {
            const float wv = w[(size_t)k * 6144];
#pragma unroll
            for (int r = 0; r < 9; ++r) acc[r] += sl[r * 128 + k] * wv;
        }
#pragma unroll
        for (int r = 0; r < 9; ++r) modp[((size_t)(l * 8 + ks) * 9 + r) * 6144 + col] = acc[r];
    }
    float2* rope = (float2*)(p.ws + OFF_ROPE);
    for (int e = p.bid * NTHREADS + tid; e < 2048 * 32; e += p.nblk * NTHREADS) {
        const int t = e >> 5, a = (e >> 4) & 1, i = e & 15;
        const float freq = exp2f(-(float)i * (13.287712379549449f / 16.0f));
        const float pos = (float)(a == 0 ? (t >> 6) : (t & 63));
        const float ang = pos * freq;
        rope[e] = make_float2(cosf(ang), sinf(ang));
    }
    float* lb = (float*)(p.ws + OFF_LB);
    for (int e = p.bid * NTHREADS + tid; e < 2 * 512; e += p.nblk * NTHREADS) {
        const int d = e >> 9, c = e & 511;
        const float h0 = p.in[I_HLB][(d * 2 + 0) * 512 + c], h1 = p.in[I_HLB][(d * 2 + 1) * 512 + c];
        const float mx = fmaxf(h0, h1);
        const float e0 = expf(h0 - mx), e1 = expf(h1 - mx);
        const float p1 = e1 / (e0 + e1);
        lb[(d * 2 + 0) * 512 + c] = 0.f;
        lb[(d * 2 + 1) * 512 + c] = p1;
    }
    if (p.bid == 0 && tid < 2) {
        const int l = tid;
        float s1 = 0.f, s2 = 0.f;
        for (int i = 0; i < 64; ++i) {
            s1 += p.in[I_LQ1][l * 64 + i] * p.in[I_LK1][l * 64 + i];
            s2 += p.in[I_LQ2][l * 64 + i] * p.in[I_LK2][l * 64 + i];
        }
        const float lam_init = 0.8f - 0.6f * expf(-0.3f * (float)l);
        float* lam = (float*)(p.ws + OFF_LAM);
        lam[l * 2 + 0] = expf(s1) - expf(s2) + lam_init;
        lam[l * 2 + 1] = lam_init;
    }
}

__device__ __forceinline__ void phase_p0b(const DP& p, int tid) {
    const float* modp = (const float*)(p.ws + OFF_MODP);
    float* mod = (float*)(p.ws + OFF_MOD);
    for (int e = p.bid * NTHREADS + tid; e < 2 * 9 * 6144; e += p.nblk * NTHREADS) {
        const int l = e / (9 * 6144), rem = e % (9 * 6144), r = rem / 6144, col = rem % 6144;
        float s = p.in[I_BMOD][l * 6144 + col];
#pragma unroll
        for (int ks = 0; ks < 8; ++ks) s += modp[((size_t)(l * 8 + ks) * 9 + r) * 6144 + col];
        mod[e] = s;
    }
}

__device__ __forceinline__ void norm_pass(const DP& p, int l, int which, int tid) {
    const int lane = tid & 63;
    const int gw = p.bid * 4 + (tid >> 6), nw = p.nblk * 4;
    const float* gvec = p.in[which ? I_N2G : I_N1G] + l * DM;
    const float* mod = (const float*)(p.ws + OFF_MOD) + (size_t)l * 9 * 6144;
    float* X = (float*)(p.ws + OFF_X);
    bf16_t* HX = (bf16_t*)(p.ws + OFF_HX);
    const int seg_sh = which ? 3 : 0, seg_sc = which ? 4 : 1;
    for (int row = gw; row < RR; row += nw) {
        const int b = row / TU, t = row - b * TU;
        const bool isctx = t >= SEQ;
        if (which == 1 && l == 1 && isctx) continue;
        const float* src;
        if (which == 0 && l == 0) src = isctx ? p.in[I_CTX] + (size_t)(b * CTXL + t - SEQ) * DM : p.in[I_X] + (size_t)(b * SEQ + t) * DM;
        else src = X + (size_t)row * DM;
        const float* mrow = mod + (isctx ? 8 : b) * 6144;
        f32x4 v[4]; float ss = 0.f;
#pragma unroll
        for (int j = 0; j < 4; ++j) {
            v[j] = *(const f32x4*)(src + j * 256 + lane * 4);
            ss += v[j][0] * v[j][0] + v[j][1] * v[j][1] + v[j][2] * v[j][2] + v[j][3] * v[j][3];
        }
        ss = wave_sum(ss);
        const float rstd = rsqrtf(ss * (1.0f / 1024.0f) + 1e-6f);
#pragma unroll
        for (int j = 0; j < 4; ++j) {
            const int col = j * 256 + lane * 4;
            if (which == 0 && l == 0) *(f32x4*)(X + (size_t)row * DM + col) = v[j];
            const f32x4 g4 = *(const f32x4*)(gvec + col);
            const f32x4 sh = *(const f32x4*)(mrow + seg_sh * 1024 + col);
            const f32x4 sc = *(const f32x4*)(mrow + seg_sc * 1024 + col);
            float y[4];
#pragma unroll
            for (int i = 0; i < 4; ++i) y[i] = v[j][i] * rstd * g4[i] * (1.0f + sc[i]) + sh[i];
            u32x2 w; w.x = pack2(y[0], y[1]); w.y = pack2(y[2], y[3]);
            *(u32x2*)(HX + (size_t)row * DM + col) = w;
        }
    }
}

__device__ __forceinline__ void conv_tr64(const float* src, int ld, int srccol, int k0, int K, bf16_t* dst, const float* fold, float* lt, int tid, bool perm = false) {
    __syncthreads();
#pragma unroll
    for (int i = 0; i < 4; ++i) {
        const int r = (tid >> 4) + 16 * i, c4 = tid & 15;
        f32x4 val = {0.f, 0.f, 0.f, 0.f};
        if (srccol >= 0) val = *(const f32x4*)(src + (size_t)(k0 + r) * ld + srccol + c4 * 4);
        if (fold) { const float f = fold[k0 + r]; val = val * f; }
        lt[r * 65 + c4 * 4 + 0] = val[0]; lt[r * 65 + c4 * 4 + 1] = val[1]; lt[r * 65 + c4 * 4 + 2] = val[2]; lt[r * 65 + c4 * 4 + 3] = val[3];
    }
    __syncthreads();
    const int n = tid >> 2, seg = tid & 3;
    unsigned w[8];
#pragma unroll
    for (int i = 0; i < 8; ++i) w[i] = pack2(lt[(seg * 16 + 2 * i) * 65 + n], lt[(seg * 16 + 2 * i + 1) * 65 + n]);
    const int nrow = perm ? (((n >> 4) & 1) * 32 + ((n >> 2) & 1) * 16 + (n >> 5) * 8 + ((n >> 3) & 1) * 4 + (n & 3)) : n;
    bf16_t* d = dst + (size_t)nrow * K + k0 + seg * 16;
    u32x4 a = {w[0], w[1], w[2], w[3]}, bq = {w[4], w[5], w[6], w[7]};
    *(u32x4*)d = a; *(u32x4*)(d + 8) = bq;
}

__device__ __forceinline__ int win_srccol(int chunk) {
    if (chunk < 8) return (chunk & 1) * 256 + (chunk >> 1) * 64;
    if (chunk < 16) return 512 + (chunk - 8) * 64;
    if (chunk < 22) return 1536 + (chunk - 16) * 64;
    if (chunk < 30) return 4032 + (chunk - 22) * 64;
    if (chunk < 40) return 4544 + (chunk - 30) * 64;
    if (chunk == 40) return 1920;
    return -1;
}
__device__ __forceinline__ int wt_srccol(int chunk) {
    if (chunk < 8) return 1024 + chunk * 64;
    if (chunk < 10) return 5184 + (chunk - 8) * 64;
    return 1984 + (chunk - 10) * 64;
}

__device__ __forceinline__ void conv_weights(const DP& p, int l, char* lds, int tid, int part = 0) {
    float* lt = (float*)lds;
    const float* w_in = p.in[I_WIN] + (size_t)l * DM * 9408;
    const int n_main = 42 * 16, n_v = 42 * 16, n_g = 64 * 16, n_uq = 12 * 4, n_uk = 8 * 2, n_uv = 8 * 2, n_br = 4 * 16 * 8, n_out = 256, n_pq = 256, n_keys = 64;
    const int total = n_main + n_v + n_g + n_uq + n_uk + n_uv + n_br + n_out + n_pq + n_keys;
    const int lo = part == 2 ? total - n_pq - n_keys : 0, hi = part == 1 ? total - n_pq - n_keys : total;
    unsigned* qctr = (unsigned*)(p.ws + OFF_BAR) + 3520 + 64 * (l & 1) + 48;
    volatile int* slot = (volatile int*)(lds + 73728 + 992);
    asm volatile("s_waitcnt vmcnt(0)" ::: "memory");
    __syncthreads();
    for (int it0 = lo + p.bid; ; it0 += p.nblk) {
        if (part == 1) {
            __syncthreads();
            if (tid == 0) *slot = (int)atomicAdd(qctr, 1u);
            __syncthreads();
            it0 = lo + *slot;
        }
        if (it0 >= hi) break;
        int it = it0;
        if (it < n_main) { const int ch = it >> 4, kb = it & 15;
            conv_tr64(w_in, 9408, win_srccol(ch), kb * 64, 1024, (bf16_t*)(p.ws + OFF_WIN) + (size_t)ch * 64 * 1024, nullptr, lt, tid, true); continue; }
        it -= n_main;
        if (it < n_v) { const int ch = it >> 4, kb = it & 15;
            conv_tr64(w_in, 9408, wt_srccol(ch), kb * 64, 1024, (bf16_t*)(p.ws + OFF_WV) + (size_t)ch * 64 * 1024, nullptr, lt, tid); continue; }
        it -= n_v;
        if (it < n_g) { const int ch = it >> 4, kb = it & 15;
            conv_tr64(w_in, 9408, 5312 + ch * 64, kb * 64, 1024, (bf16_t*)(p.ws + OFF_WG) + (size_t)ch * 64 * 1024, nullptr, lt, tid); continue; }
        it -= n_g;
        if (it < n_uq) { const int ch = it >> 2, kb = it & 3;
            conv_tr64(p.in[I_WUQ] + (size_t)l * 256 * 768, 768, ch * 64, kb * 64, 256, (bf16_t*)(p.ws + OFF_WUQ) + (size_t)ch * 64 * 256, p.in[I_QNG] + l * 256, lt, tid); continue; }
        it -= n_uq;
        if (it < n_uk) { const int ch = it >> 1, kb = it & 1;
            conv_tr64(p.in[I_WUKV] + (size_t)l * 128 * 1024, 1024, (ch >> 1) * 256 + (ch & 1) * 64, kb * 64, 128, (bf16_t*)(p.ws + OFF_WUK) + (size_t)ch * 64 * 128, p.in[I_KVNG] + l * 128, lt, tid); continue; }
        it -= n_uk;
        if (it < n_uv) { const int ch = it >> 1, kb = it & 1;
            conv_tr64(p.in[I_WUKV] + (size_t)l * 128 * 1024, 1024, (ch >> 1) * 256 + 128 + (ch & 1) * 64, kb * 64, 128, (bf16_t*)(p.ws + OFF_WUV) + (size_t)ch * 64 * 128, p.in[I_KVNG] + l * 128, lt, tid); continue; }
        it -= n_uv;
        if (it < n_br) { const int j = it >> 7, r2 = it & 127, ch = r2 >> 3, kb = r2 & 7;
            conv_tr64(p.in[I_WBR] + ((size_t)l * 4 + j) * 512 * 1024, 1024, ch * 64, kb * 64, 512, (bf16_t*)(p.ws + OFF_WBR) + (size_t)j * 1024 * 512 + (size_t)ch * 64 * 512, nullptr, lt, tid); continue; }
        it -= n_br;
        if (it < n_out) { const int ch = it >> 4, kb = it & 15;
            conv_tr64(p.in[I_WOUT] + (size_t)l * 1024 * 1024, 1024, ch * 64, kb * 64, 1024, (bf16_t*)(p.ws + OFF_WOUT) + (size_t)ch * 64 * 1024, nullptr, lt, tid); continue; }
        it -= n_out;
        if (it < n_pq) { const int ch = it >> 4, kb = it & 15;
            conv_tr64(p.in[I_PWQ] + (size_t)l * 1024 * 1024, 1024, ch * 64, kb * 64, 1024, (bf16_t*)(p.ws + OFF_WPQ) + (size_t)ch * 64 * 1024, nullptr, lt, tid); continue; }
        it -= n_pq;
        {
            const float* ks = p.in[I_PKEYS] + (size_t)l * 131072 + (size_t)it * 2048 + tid * 8;
            const f32x4 a = *(const f32x4*)ks, bq = *(const f32x4*)(ks + 4);
            u32x4 w = {pack2(a[0], a[1]), pack2(a[2], a[3]), pack2(bq[0], bq[1]), pack2(bq[2], bq[3])};
            *(u32x4*)((bf16_t*)(p.ws + KEYS_OFF(l)) + (size_t)it * 2048 + tid * 8) = w;
        }
    }
    __syncthreads();
}

#ifndef EB
#define EB 2
#endif
#define TROW 768
#ifndef FAKEIDX
#define FAKEIDX 0
#endif
#define DEPTH_ 2
#ifndef FOLD_ALL
#define FOLD_ALL 1
#endif
#ifndef CONVW_IN8
#define CONVW_IN8 0
#endif
#ifndef NODEC
#define NODEC 0
#endif
#ifndef SKIP
#define SKIP 0
#endif
__device__ __forceinline__ unsigned enc_e2m3(float x, float inv) {
    const float a = fabsf(x) * inv;
    float cf;
    if (a < 2.0f) cf = rintf(a * 8.0f); else if (a < 4.0f) cf = 16.0f + rintf((a - 2.0f) * 4.0f); else cf = 24.0f + rintf((a - 4.0f) * 2.0f);
    unsigned code = (unsigned)fminf(cf, 31.0f);
    return code | ((__float_as_uint(x) >> 31) << 5);
}
#define NCONV 512
__device__ __forceinline__ void conv_tables_item(const DP& p, int l, int item, int tid) {
    const int lane = tid & 63;
    const int j = lane >> 4, c = lane & 15;
    {
        const int tb = item >> 8;
        const int rbase = (item & 255) * 64 + (tid >> 6) * 16;
        const float* src = p.in[tb ? I_PV : I_PU] + (size_t)l * 16384 * 1024;
        unsigned char* dst = (unsigned char*)(p.ws + (tb ? OFF_TV : OFF_TU));
        float* scl = (float*)(p.ws + (tb ? OFF_SV : OFF_SU));
#pragma unroll 1
        for (int r0 = rbase; r0 < rbase + 16; r0 += 2) {
            f32x4 a[2][4];
#pragma unroll
            for (int rr = 0; rr < 2; ++rr)
#pragma unroll
                for (int q = 0; q < 4; ++q) a[rr][q] = *(const f32x4*)(src + (size_t)(r0 + rr) * 1024 + lane * 16 + q * 4);
#pragma unroll
            for (int rr = 0; rr < 2; ++rr) {
                float mx = 0.f;
#pragma unroll
                for (int q = 0; q < 4; ++q)
#pragma unroll
                    for (int i = 0; i < 4; ++i) mx = fmaxf(mx, fabsf(a[rr][q][i]));
#pragma unroll
                for (int o = 32; o >= 1; o >>= 1) mx = fmaxf(mx, __shfl_xor(mx, o));
                mx = fmaxf(mx, 1e-30f);
                const float inv = 7.5f / mx;
                unsigned d0 = 0u, d1 = 0u, d2 = 0u;
#pragma unroll
                for (int t = 0; t < 16; ++t) {
                    const unsigned code = enc_e2m3(a[rr][t >> 2][t & 3], inv);
                    const int bit = 6 * t, w = bit >> 5, sh = bit & 31;
                    if (w == 0) d0 |= code << sh; else if (w == 1) d1 |= code << sh; else d2 |= code << sh;
                    if (sh > 26) { if (w == 0) d1 |= code >> (32 - sh); else d2 |= code >> (32 - sh); }
                }
                unsigned char* o = dst + (size_t)(r0 + rr) * TROW + c * 16;
                const int n0 = 3 * j;
                *(unsigned*)(o + (n0 >> 2) * 256 + (n0 & 3) * 4) = d0;
                *(unsigned*)(o + ((n0 + 1) >> 2) * 256 + ((n0 + 1) & 3) * 4) = d1;
                *(unsigned*)(o + ((n0 + 2) >> 2) * 256 + ((n0 + 2) & 3) * 4) = d2;
                if (lane == 0) scl[r0 + rr] = mx * (1.0f / 7.5f);
            }
        }
    }
}

template <int BN, bool SWAP>
__device__ __forceinline__ void gemm_core(const bf16_t* __restrict__ A, int lda, const bf16_t* __restrict__ Bt, int ldb, int K,
                                          f32x4 (&acc)[4][BN / 32], char* lds, int tid,
                                          int& par, bool pre = false, const bf16_t* An = nullptr, int ldan = 0, const bf16_t* Bn = nullptr, int ldbn = 0) {
    constexpr int NF = BN / 32, NBL = BN / 32;
    const int lane = tid & 63, wid = tid >> 6, wr = wid >> 1, wc = wid & 1, g = lane >> 4, c = lane & 15;
    char* As = lds;
    char* Bs = lds + 32768;
    const int nk = K >> 6;
    const int srow = wid * 8 + (lane >> 3), scc = (lane & 7) ^ (lane >> 3);
    auto stage = [&](const bf16_t* Ab, int lda_, const bf16_t* Bb, int ldb_, int kt, int buf) {
        const bf16_t* a_src = Ab + (size_t)srow * lda_ + scc * 8;
        const bf16_t* b_src = Bb + (size_t)srow * ldb_ + scc * 8;
#pragma unroll
        for (int i = 0; i < 4; ++i)
            __builtin_amdgcn_global_load_lds((const unsigned*)(a_src + (size_t)i * 32 * lda_ + kt * 64), (LAS unsigned*)(As + buf * 16384 + (i * 4 + wid) * 1024), 16, 0, 0);
#pragma unroll
        for (int i = 0; i < NBL; ++i)
            __builtin_amdgcn_global_load_lds((const unsigned*)(b_src + (size_t)i * 32 * ldb_ + kt * 64), (LAS unsigned*)(Bs + buf * (BN * 128) + (i * 4 + wid) * 1024), 16, 0, 0);
    };
    const char* a_rd[2]; const char* b_rd[2];
#pragma unroll
    for (int kk = 0; kk < 2; ++kk) {
        a_rd[kk] = As + (wr * 64 + c) * 128 + (((kk * 4 + g) ^ (c & 7)) << 4);
        b_rd[kk] = Bs + (wc * (BN / 2) + c) * 128 + (((kk * 4 + g) ^ (c & 7)) << 4);
    }
    if (!pre) {
        __syncthreads();
        stage(A, lda, Bt, ldb, 0, par);
        asm volatile("s_waitcnt vmcnt(0)" ::: "memory");
        __syncthreads();
    }
    for (int kt = 0; kt < nk; ++kt) {
        const int buf = (par + kt) & 1;
        if (kt + 1 < nk) stage(A, lda, Bt, ldb, kt + 1, buf ^ 1);
        else if (An) stage(An, ldan, Bn, ldbn, 0, buf ^ 1);
#pragma unroll
        for (int kk = 0; kk < 2; ++kk) {
            bf16x8 af[4], bfr[NF];
#pragma unroll
            for (int m = 0; m < 4; ++m) af[m] = *(const bf16x8*)(a_rd[kk] + buf * 16384 + m * 2048);
#pragma unroll
            for (int n = 0; n < NF; ++n) bfr[n] = *(const bf16x8*)(b_rd[kk] + buf * (BN * 128) + n * 2048);
#pragma unroll
            for (int m = 0; m < 4; ++m)
#pragma unroll
                for (int n = 0; n < NF; ++n)
                    acc[m][n] = SWAP ? __builtin_amdgcn_mfma_f32_16x16x32_bf16(bfr[n], af[m], acc[m][n], 0, 0, 0)
                                     : __builtin_amdgcn_mfma_f32_16x16x32_bf16(af[m], bfr[n], acc[m][n], 0, 0, 0);
        }
        asm volatile("s_waitcnt vmcnt(0)" ::: "memory");
        __syncthreads();
    }
    par = (par + nk) & 1;
}

template <bool SWAP>
__device__ __forceinline__ void gemm256(const bf16_t* __restrict__ A, int lda, const bf16_t* __restrict__ Bt, int ldb, int K,
                                        f32x4 (&acc)[8][4], char* lds, int tid) {
    const int lane = tid & 63, wid = tid >> 6, wr = wid >> 1, wc = wid & 1, g = lane >> 4, c = lane & 15;
    const int nk = K >> 5;
    const int srow = wid * 16 + (lane >> 2), scc = ((lane & 3) + 2 * ((lane >> 4) & 3)) & 3;
    const bf16_t* a_src = A + (size_t)srow * lda + scc * 8;
    const bf16_t* b_src = Bt + (size_t)srow * ldb + scc * 8;
    auto stage = [&](int kt, int boff) {
#pragma unroll
        for (int i = 0; i < 4; ++i)
            __builtin_amdgcn_global_load_lds((const unsigned*)(a_src + (size_t)i * 64 * lda + kt * 32), (LAS unsigned*)(lds + boff + (i * 4 + wid) * 1024), 16, 0, 0);
#pragma unroll
        for (int i = 0; i < 2; ++i)
            __builtin_amdgcn_global_load_lds((const unsigned*)(b_src + (size_t)i * 64 * ldb + kt * 32), (LAS unsigned*)(lds + boff + 16384 + (i * 4 + wid) * 1024), 16, 0, 0);
    };
    const int slot = ((g + 2 * (c >> 2)) & 3) << 4;
    const char* a_rd = lds + (wr * 128 + c) * 64 + slot;
    const char* b_rd = lds + 16384 + (wc * 64 + c) * 64 + slot;
    __syncthreads();
    stage(0, 0);
    stage(1, 24576);
    int cur = 0, nxt2 = 49152;
    for (int kt = 0; kt < nk; ++kt) {
        if (kt + 1 < nk) asm volatile("s_waitcnt vmcnt(6)" ::: "memory"); else asm volatile("s_waitcnt vmcnt(0)" ::: "memory");
        __builtin_amdgcn_s_barrier();
        asm volatile("" ::: "memory");
        if (kt + 2 < nk) stage(kt + 2, nxt2);
        bf16x8 af[8], bfr[4];
#pragma unroll
        for (int m = 0; m < 8; ++m) af[m] = *(const bf16x8*)(a_rd + cur + m * 1024);
#pragma unroll
        for (int n = 0; n < 4; ++n) bfr[n] = *(const bf16x8*)(b_rd + cur + n * 1024);
#pragma unroll
        for (int m = 0; m < 8; ++m)
#pragma unroll
            for (int n = 0; n < 4; ++n)
                acc[m][n] = SWAP ? __builtin_amdgcn_mfma_f32_16x16x32_bf16(bfr[n], af[m], acc[m][n], 0, 0, 0)
                                 : __builtin_amdgcn_mfma_f32_16x16x32_bf16(af[m], bfr[n], acc[m][n], 0, 0, 0);
        nxt2 = cur; cur = (cur == 49152) ? 0 : cur + 24576;
    }
    asm volatile("s_waitcnt lgkmcnt(0)" ::: "memory");
}

template <int MF, int NF>
__device__ __forceinline__ void zero_acc(f32x4 (&acc)[MF][NF]) {
#pragma unroll
    for (int m = 0; m < MF; ++m)
#pragma unroll
        for (int n = 0; n < NF; ++n) acc[m][n] = (f32x4){0.f, 0.f, 0.f, 0.f};
}

#ifndef BKT
#define BKT 64
#endif
#define QSCALE64 (0.125f * LOG2E)
#define QSCALE192 (0.07216878364870322f * LOG2E)

struct TileIter {
    int x, lb, nlb, NT, RS, per, total, lt, NM; bool xcd;
    __device__ __forceinline__ void init(const DP& p, int NT_, int RS_, int NM_ = 144) {
        NT = NT_; RS = RS_; NM = NM_; xcd = (p.nblk & 7) == 0 && p.nblk >= 8;
        if (xcd) { x = p.bid & 7; lb = p.bid >> 3; nlb = p.nblk >> 3; per = RS * NT; total = (NM / 8) * NT; }
        else { x = 0; lb = p.bid; nlb = p.nblk; per = 1; total = NM * NT; }
        lt = lb;
    }
    __device__ __forceinline__ bool next(int& tm, int& tn) {
        if (lt >= total) return false;
        if (xcd) { const int rg = lt / per, rem = lt - rg * per; tn = rem / RS; const int r = rem - tn * RS; tm = (rg * RS + r) * 8 + x; }
        else { tn = lt / NM; tm = lt - tn * NM; }
        lt += nlb;
        return true;
    }
};

__device__ __forceinline__ void phase_inproj(const DP& p, int l, char* lds, int tid, int fake = 0) {
    const int lane = tid & 63, wid = tid >> 6, wr = wid >> 1, wc = wid & 1, g = lane >> 4, c = lane & 15;
    const bf16_t* HX = (const bf16_t*)(p.ws + OFF_HX);
    bf16_t* P = (bf16_t*)(p.ws + OFF_P);
    bf16_t* KB = (bf16_t*)(p.ws + OFF_KB);
    const float* lb = (const float*)(p.ws + OFF_LB);
    float rfreq[2][4];
#pragma unroll
    for (int H = 0; H < 2; ++H)
#pragma unroll
        for (int r = 0; r < 4; ++r) rfreq[H][r] = exp2f(-(float)(8 * (g & 1) + 4 * H + r) * (13.287712379549449f / 16.0f)) * 0.15915494309189535f;
    TileIter ti; ti.init(p, 42, 9, 72);
    int tm, tn_all;
    while (ti.next(tm, tn_all)) {
        if (tn_all < 21) {
            const int tn = tn_all;
            const int row0 = tm * 256, col0 = tn * 128;
            f32x4 acc[8][4]; zero_acc<8, 4>(acc);
            if (fake) {
                const int fr = (fake == 1) ? 0 : row0, fc = (fake == 1) ? 0 : col0;
                gemm256<true>(HX + (size_t)fr * DM, DM, (const bf16_t*)(p.ws + OFF_WIN) + (size_t)fc * DM, DM, DM, acc, lds, tid);
#pragma unroll
                for (int m = 0; m < 8; ++m)
#pragma unroll
                    for (int n = 0; n < 4; ++n) asm volatile("" :: "v"(acc[m][n]));
                continue;
            }
            gemm256<true>(HX + (size_t)row0 * DM, DM, (const bf16_t*)(p.ws + OFF_WIN) + (size_t)col0 * DM, DM, DM, acc, lds, tid);
            __syncthreads();
            const int chunk = (col0 >> 6) + wc;
            if (chunk >= 41) continue;
            const bool is_rope = (chunk < 16) || (chunk >= 30);
            const bool is_q = (chunk < 8) || (chunk >= 30 && chunk < 38);
            const int pcol = chunk * 64 + (chunk >= 22 ? 512 : 0);
            const int fA = g >> 1, fB = g & 1;
#pragma unroll
            for (int m = 0; m < 8; ++m) {
                const int row = row0 + wr * 128 + m * 16 + c;
                const int b = row / TU, t = row - b * TU;
                f32x4 v[4];
#pragma unroll
                for (int n = 0; n < 4; ++n) v[n] = acc[m][n];
                if (is_rope && t < SEQ) {
                    const float pos = (float)(fA == 0 ? (t >> 6) : (t & 63));
#pragma unroll
                    for (int H = 0; H < 2; ++H)
#pragma unroll
                        for (int r = 0; r < 4; ++r) {
                            const float a0 = pos * rfreq[H][r];
                            const float cs = __builtin_amdgcn_cosf(a0), sn = __builtin_amdgcn_sinf(a0);
                            const float x1 = v[H][r], x2 = v[2 + H][r];
                            v[H][r] = x1 * cs - x2 * sn; v[2 + H][r] = x1 * sn + x2 * cs;
                        }
                }
                if (is_q) {
#pragma unroll
                    for (int n = 0; n < 4; ++n) v[n] = v[n] * QSCALE64;
                }
#pragma unroll
                for (int P2 = 0; P2 < 2; ++P2) {
                    u32x4 w; w.x = pack2(v[2 * P2][0], v[2 * P2][1]); w.y = pack2(v[2 * P2][2], v[2 * P2][3]);
                    w.z = pack2(v[2 * P2 + 1][0], v[2 * P2 + 1][1]); w.w = pack2(v[2 * P2 + 1][2], v[2 * P2 + 1][3]);
                    const int fo = 32 * fA + 16 * P2 + 8 * fB;
                    if (chunk < 40) *(u32x4*)(P + (size_t)row * PW + pcol + fo) = w;
                    else {
#pragma unroll
                        for (int h = 0; h < 4; ++h) *(u32x4*)(KB + (size_t)row * 768 + h * 192 + 128 + fo) = w;
                    }
                }
            }
        } else {
            const int tn = tn_all - 21;
            const int row0 = tm * 256, col0 = tn * 128;
            f32x4 acc[8][4]; zero_acc<8, 4>(acc);
            if (fake) {
                const int fr = (fake == 1) ? 0 : row0, fc = (fake == 1) ? 0 : col0;
                gemm256<false>(HX + (size_t)fr * DM, DM, (const bf16_t*)(p.ws + OFF_WV) + (size_t)fc * DM, DM, DM, acc, lds, tid);
#pragma unroll
                for (int m = 0; m < 8; ++m)
#pragma unroll
                    for (int n = 0; n < 4; ++n) asm volatile("" :: "v"(acc[m][n]));
                continue;
            }
            gemm256<false>(HX + (size_t)row0 * DM, DM, (const bf16_t*)(p.ws + OFF_WV) + (size_t)col0 * DM, DM, DM, acc, lds, tid);
            const int chunk = (col0 >> 6) + wc;
#pragma unroll
            for (int m = 0; m < 8; ++m) {
                const int rowb = row0 + wr * 128 + m * 16 + 4 * g;
                const int b = rowb / TU, t = rowb - b * TU;
#pragma unroll
                for (int n = 0; n < 4; ++n) {
                    f32x4 v = acc[m][n];
                    bf16_t* dst;
                    if (chunk < 8) dst = (bf16_t*)(p.ws + OFF_VTA) + ((size_t)((b * 4 + (chunk >> 1)) * 128 + (chunk & 1) * 64 + n * 16 + c)) * TU + t;
                    else if (chunk < 10) dst = (bf16_t*)(p.ws + OFF_VTD) + ((size_t)((b * 2 + (chunk - 8)) * 64 + n * 16 + c)) * TU + t;
                    else {
                        const int ci = chunk - 10, arr = ci >> 3, col = (ci & 7) * 64 + n * 16 + c;
                        if (arr == 1 || arr == 2) {
                            const float lbv = lb[((arr - 1) * 2 + l) * 512 + col];
#pragma unroll
                            for (int r = 0; r < 4; ++r) v[r] = (1.0f - lbv) / (1.0f + __expf(v[r]));
                        }
                        dst = (bf16_t*)(p.ws + OFF_HT) + ((size_t)(((b * 4 + (col >> 7)) * 4 + arr) * 128 + (col & 127))) * TU + t;
                    }
                    u32x2 w; w.x = pack2(v[0], v[1]); w.y = pack2(v[2], v[3]);
                    *(u32x2*)dst = w;
                }
            }
        }
    }
}

__device__ __forceinline__ void row_rstd(const bf16_t* A, int lda, int K, float* rs, int tid) {
    __syncthreads();
    const int r = tid >> 1, half = tid & 1;
    const int n = K >> 1;
    const bf16_t* ap = A + (size_t)r * lda + half * n;
    float ss = 0.f;
    for (int i = 0; i < n; i += 8) {
        const u32x4 w = *(const u32x4*)(ap + i);
#pragma unroll
        for (int j = 0; j < 4; ++j) { const float a = bflo(w[j]), bq = bfhi(w[j]); ss += a * a + bq * bq; }
    }
    ss += __shfl_xor(ss, 1);
    if (half == 0) rs[r] = rsqrtf(ss / (float)K + 1e-6f);
    __syncthreads();
}

__device__ __forceinline__ void phase_mla(const DP& p, int l, char* lds, int tid) {
    const int lane = tid & 63, wid = tid >> 6, wr = wid >> 1, wc = wid & 1, g = lane >> 4, c = lane & 15;
    const bf16_t* P = (const bf16_t*)(p.ws + OFF_P);
    bf16_t* QB = (bf16_t*)(p.ws + OFF_QB);
    bf16_t* KB = (bf16_t*)(p.ws + OFF_KB);
    float rfreq[4];
#pragma unroll
    for (int r = 0; r < 4; ++r) rfreq[r] = exp2f(-(float)(4 * g + r) * (13.287712379549449f / 16.0f)) * 0.15915494309189535f;
    float* rs = (float*)(lds + LDS_MISC);
    TileIter ti; ti.init(p, 14, 18);
    int tm, tn_all;
    while (ti.next(tm, tn_all)) {
        if (tn_all < 6) {
            const int tn = tn_all, row0 = tm * 128, col0 = tn * 128;
            const bf16_t* A = P + (size_t)row0 * PW + PC_CQ;
            row_rstd(A, PW, 256, rs, tid);
            f32x4 acc[4][4]; zero_acc<4, 4>(acc);
            { int par0 = 0; gemm_core<128, true>(A, PW, (const bf16_t*)(p.ws + OFF_WUQ) + (size_t)col0 * 256, 256, 256, acc, lds, tid, par0); }
            const int chunk = (col0 >> 6) + wc;
            const bool is_rope = (chunk % 3) == 2;
#pragma unroll
            for (int m = 0; m < 4; ++m) {
                const int rl = wr * 64 + m * 16 + c, row = row0 + rl;
                const int b = row / TU, t = row - b * TU;
                const float sc = rs[rl] * QSCALE192;
                f32x4 v[4];
#pragma unroll
                for (int n = 0; n < 4; ++n) v[n] = acc[m][n] * sc;
                if (is_rope && t < SEQ) {
#pragma unroll
                    for (int r = 0; r < 4; ++r) {
                        const float fr = rfreq[r];
                        const float a0 = (float)(t >> 6) * fr, a1 = (float)(t & 63) * fr;
                        const float2 cs0 = make_float2(__builtin_amdgcn_cosf(a0), __builtin_amdgcn_sinf(a0)), cs1 = make_float2(__builtin_amdgcn_cosf(a1), __builtin_amdgcn_sinf(a1));
                        const float x1 = v[0][r], x2 = v[1][r], y1 = v[2][r], y2 = v[3][r];
                        v[0][r] = x1 * cs0.x - x2 * cs0.y; v[1][r] = x1 * cs0.y + x2 * cs0.x;
                        v[2][r] = y1 * cs1.x - y2 * cs1.y; v[3][r] = y1 * cs1.y + y2 * cs1.x;
                    }
                }
#pragma unroll
                for (int n = 0; n < 4; ++n) {
                    u32x2 w; w.x = pack2(v[n][0], v[n][1]); w.y = pack2(v[n][2], v[n][3]);
                    *(u32x2*)(QB + (size_t)row * 768 + chunk * 64 + n * 16 + 4 * g) = w;
                }
            }
        } else if (tn_all < 10) {
            const int tn = tn_all - 6, row0 = tm * 128, col0 = tn * 128;
            const bf16_t* A = P + (size_t)row0 * PW + PC_CKV;
            row_rstd(A, PW, 128, rs, tid);
            f32x4 acc[4][4]; zero_acc<4, 4>(acc);
            { int par0 = 0; gemm_core<128, true>(A, PW, (const bf16_t*)(p.ws + OFF_WUK) + (size_t)col0 * 128, 128, 128, acc, lds, tid, par0); }
#pragma unroll
            for (int m = 0; m < 4; ++m) {
                const int rl = wr * 64 + m * 16 + c, row = row0 + rl;
                const float sc = rs[rl];
#pragma unroll
                for (int n = 0; n < 4; ++n) {
                    const f32x4 v = acc[m][n] * sc;
                    u32x2 w; w.x = pack2(v[0], v[1]); w.y = pack2(v[2], v[3]);
                    *(u32x2*)(KB + (size_t)row * 768 + tn * 192 + wc * 64 + n * 16 + 4 * g) = w;
                }
            }
        } else {
            const int tn = tn_all - 10, row0 = tm * 128, col0 = tn * 128;
            const bf16_t* A = P + (size_t)row0 * PW + PC_CKV;
            row_rstd(A, PW, 128, rs, tid);
            f32x4 acc[4][4]; zero_acc<4, 4>(acc);
            { int par0 = 0; gemm_core<128, false>(A, PW, (const bf16_t*)(p.ws + OFF_WUV) + (size_t)col0 * 128, 128, 128, acc, lds, tid, par0); }
#pragma unroll
            for (int m = 0; m < 4; ++m) {
                const int rl = wr * 64 + m * 16 + 4 * g, rowb = row0 + rl;
                const int b = rowb / TU, t = rowb - b * TU;
                const float s0 = rs[rl], s1 = rs[rl + 1], s2 = rs[rl + 2], s3 = rs[rl + 3];
#pragma unroll
                for (int n = 0; n < 4; ++n) {
                    u32x2 w; w.x = pack2(acc[m][n][0] * s0, acc[m][n][1] * s1); w.y = pack2(acc[m][n][2] * s2, acc[m][n][3] * s3);
                    *(u32x2*)((bf16_t*)(p.ws + OFF_VTB) + ((size_t)((b * 4 + tn) * 128 + wc * 64 + n * 16 + c)) * TU + t) = w;
                }
            }
        }
    }
}

template <int DQK, int DV, int KT, bool WIN, int LDQ, int LDK, int LDO>
__device__ __forceinline__ void attn_item(const bf16_t* Qp, const bf16_t* __restrict__ Kp, const bf16_t* __restrict__ Vt, bf16_t* Op,
                          int seg0_start, int seg0_tiles, int seg1_start, int seg1_tiles, int qpos0,
                          float m_init, float l_init, char* lds, int tid) {
    constexpr int KS = DQK / 32, DT = DV / 16, NSUB = DQK / 64, NKT = KT / 16, NGRP = KT / 32;
    constexpr int KP = KT * 8 / 256;
    constexpr int NVC = DV * (KT / 8) / 256;
    constexpr int KROW = DQK * 2;
    const int lane = tid & 63, w = tid >> 6, g = lane >> 4, c = lane & 15;
    char* Ks = lds;
    char* Vs = lds + KT * KROW;
    bf16x8 qf[2][KS];
#pragma unroll
    for (int qt = 0; qt < 2; ++qt)
#pragma unroll
        for (int ks = 0; ks < KS; ++ks) qf[qt][ks] = *(const bf16x8*)(Qp + (size_t)(w * 32 + qt * 16 + c) * LDQ + ks * 32 + 8 * g);
    f32x4 O[DT][2];
#pragma unroll
    for (int dt = 0; dt < DT; ++dt) { O[dt][0] = (f32x4){0.f, 0.f, 0.f, 0.f}; O[dt][1] = (f32x4){0.f, 0.f, 0.f, 0.f}; }
    constexpr bool FOLD = FOLD_ALL || (DQK == 64 && DV == 128);
    constexpr bool LSUM = (DQK == 64);
    float mrun[2] = {m_init, m_init};
    float lrun[2] = {g == 0 ? l_init : 0.f, g == 0 ? l_init : 0.f};
    f32x4 OL[2] = {(f32x4){l_init, l_init, l_init, l_init}, (f32x4){l_init, l_init, l_init, l_init}};

    const int ntiles = seg0_tiles + seg1_tiles;
    const int st_r = tid >> 3, st_cc = tid & 7;
    const bf16_t* kg_base = Kp + (size_t)st_r * LDK + st_cc * 8;
    char* kl_base = Ks + st_r * KROW + ((st_cc ^ (st_r & 7)) << 4);
    const bf16_t* vg_base; char* vl_base;
    if (KT == 64) { vg_base = Vt + (size_t)(tid >> 3) * TU + (tid & 7) * 8; vl_base = Vs + (tid >> 3) * 128 + (((tid & 7) ^ ((tid >> 3) & 7)) << 4); }
    else          { vg_base = Vt + (size_t)(tid >> 2) * TU + (tid & 3) * 8; vl_base = Vs + (tid >> 2) * 64 + (((tid & 3) ^ ((tid >> 4) & 3)) << 4); }
    const char* kf_base = Ks + (8 * (c >> 2) + (c & 3)) * KROW + ((g ^ (c & 3)) << 4);
    const char* vf_base0; const char* vf_base1;
    if (KT == 64) { vf_base0 = Vs + c * 128 + ((0 ^ ((c >> 2) & 1)) << 6) + ((g ^ (c & 3)) << 4); vf_base1 = Vs + c * 128 + ((1 ^ ((c >> 2) & 1)) << 6) + ((g ^ (c & 3)) << 4); }
    else          { vf_base0 = Vs + c * 64 + ((g ^ ((c >> 2) & 3)) << 4); vf_base1 = vf_base0; }
    u32x4 kreg[NSUB * KP], vreg[NVC];
    auto gload_k = [&](int ti) {
        const int key0 = ti < seg0_tiles ? seg0_start + KT * ti : seg1_start + KT * (ti - seg0_tiles);
        const bf16_t* kp = kg_base + (size_t)key0 * LDK;
#pragma unroll
        for (int sub = 0; sub < NSUB; ++sub)
#pragma unroll
            for (int i = 0; i < KP; ++i) kreg[sub * KP + i] = *(const u32x4*)(kp + (size_t)i * 32 * LDK + sub * 64);
    };
    auto gload_v = [&](int ti) {
        const int key0 = ti < seg0_tiles ? seg0_start + KT * ti : seg1_start + KT * (ti - seg0_tiles);
        const bf16_t* vp = vg_base + key0;
#pragma unroll
        for (int i = 0; i < NVC; ++i) vreg[i] = *(const u32x4*)(vp + (size_t)i * (KT == 64 ? 32 : 64) * TU);
    };
    auto gload = [&](int ti) { gload_k(ti); gload_v(ti); };
    auto lstore = [&]() {
#pragma unroll
        for (int sub = 0; sub < NSUB; ++sub)
#pragma unroll
            for (int i = 0; i < KP; ++i) *(u32x4*)(kl_base + i * 32 * KROW + sub * 128) = kreg[sub * KP + i];
#pragma unroll
        for (int i = 0; i < NVC; ++i) *(u32x4*)(vl_base + i * 4096) = vreg[i];
    };
    if (ntiles > 0) gload(0);
    for (int ti = 0; ti < ntiles; ++ti) {
        __syncthreads();
        lstore();
        __syncthreads();
        if (KS <= 2 && ti + 1 < ntiles) gload(ti + 1);
        f32x4 S[NKT][2];
        const float nb0 = (!FOLD || mrun[0] < -1e29f) ? 0.f : -mrun[0], nb1 = (!FOLD || mrun[1] < -1e29f) ? 0.f : -mrun[1];
#pragma unroll
        for (int kt = 0; kt < NKT; ++kt) { S[kt][0] = (f32x4){nb0, nb0, nb0, nb0}; S[kt][1] = (f32x4){nb1, nb1, nb1, nb1}; }
#pragma unroll
        for (int ks = 0; ks < KS; ++ks) {
#pragma unroll
            for (int kt = 0; kt < NKT; ++kt) {
                const bf16x8 kf = *(const bf16x8*)(kf_base + (32 * (kt >> 1) + 4 * (kt & 1)) * KROW + (ks >> 1) * 128 + (((ks & 1) ^ (kt & 1)) << 6));
                S[kt][0] = __builtin_amdgcn_mfma_f32_16x16x32_bf16(kf, qf[0][ks], S[kt][0], 0, 0, 0);
                S[kt][1] = __builtin_amdgcn_mfma_f32_16x16x32_bf16(kf, qf[1][ks], S[kt][1], 0, 0, 0);
            }
        }
        if (KS > 2 && ti + 1 < ntiles) gload_k(ti + 1);
        if (WIN && ti < seg0_tiles) {
            const int key0 = seg0_start + KT * ti;
#pragma unroll
            for (int qt = 0; qt < 2; ++qt) {
                const int qp = qpos0 + w * 32 + qt * 16 + c;
#pragma unroll
                for (int kt = 0; kt < NKT; ++kt)
#pragma unroll
                    for (int r = 0; r < 4; ++r) {
                        const int kp = key0 + 32 * (kt >> 1) + 8 * g + 4 * (kt & 1) + r;
                        const int d = kp - qp;
                        if (d > 128 || d < -128) S[kt][qt][r] = -1e30f;
                    }
            }
        }
        bf16x8 pf[2][NGRP];
#pragma unroll
        for (int qt = 0; qt < 2; ++qt) {
            float mx = S[0][qt][0];
#pragma unroll
            for (int kt = 0; kt < NKT; ++kt)
#pragma unroll
                for (int r = 0; r < 4; ++r) mx = fmaxf(mx, S[kt][qt][r]);
            mx = rows_max(mx);
            const float base = FOLD ? (qt ? -nb1 : -nb0) : 0.f;
            if (!__all(base + mx <= mrun[qt] + 8.0f)) {
                const float mnew = fmaxf(mrun[qt], base + mx);
                const float alpha = __builtin_amdgcn_exp2f(mrun[qt] - mnew);
                mrun[qt] = mnew;
                if (LSUM) OL[qt] = OL[qt] * alpha; else lrun[qt] *= alpha;
#pragma unroll
                for (int dt = 0; dt < DT; ++dt) O[dt][qt] = O[dt][qt] * alpha;
                if (FOLD) {
                    const float delta = mnew - base;
#pragma unroll
                    for (int kt = 0; kt < NKT; ++kt)
#pragma unroll
                        for (int r = 0; r < 4; ++r) S[kt][qt][r] -= delta;
                }
            }
            const float mcur = FOLD ? 0.f : mrun[qt];
            float ps = 0.f;
#pragma unroll
            for (int kt = 0; kt < NKT; ++kt)
#pragma unroll
                for (int r = 0; r < 4; ++r) { const float e = __builtin_amdgcn_exp2f(S[kt][qt][r] - mcur); S[kt][qt][r] = e; if (!LSUM) ps += e; }
            if (!LSUM) lrun[qt] += ps;
#pragma unroll
            for (int grp = 0; grp < NGRP; ++grp) {
                u32x4 pk;
                pk.x = pack2(S[2 * grp][qt][0], S[2 * grp][qt][1]); pk.y = pack2(S[2 * grp][qt][2], S[2 * grp][qt][3]);
                pk.z = pack2(S[2 * grp + 1][qt][0], S[2 * grp + 1][qt][1]); pk.w = pack2(S[2 * grp + 1][qt][2], S[2 * grp + 1][qt][3]);
                pf[qt][grp] = __builtin_bit_cast(bf16x8, pk);
            }
        }
        if (KS > 2 && ti + 1 < ntiles) gload_v(ti + 1);
#pragma unroll
        for (int dt = 0; dt < DT; ++dt)
#pragma unroll
            for (int grp = 0; grp < NGRP; ++grp) {
                const bf16x8 vf = *(const bf16x8*)((grp ? vf_base1 : vf_base0) + dt * 16 * (KT * 2));
                O[dt][0] = __builtin_amdgcn_mfma_f32_16x16x32_bf16(vf, pf[0][grp], O[dt][0], 0, 0, 0);
                O[dt][1] = __builtin_amdgcn_mfma_f32_16x16x32_bf16(vf, pf[1][grp], O[dt][1], 0, 0, 0);
            }
        if (LSUM) {
            unsigned one2 = 0x3F803F80u;
            asm volatile("" : "+v"(one2));
            const bf16x8 ones8 = __builtin_bit_cast(bf16x8, (u32x4){one2, one2, one2, one2});
#pragma unroll
            for (int grp = 0; grp < NGRP; ++grp) {
                OL[0] = __builtin_amdgcn_mfma_f32_16x16x32_bf16(ones8, pf[0][grp], OL[0], 0, 0, 0);
                OL[1] = __builtin_amdgcn_mfma_f32_16x16x32_bf16(ones8, pf[1][grp], OL[1], 0, 0, 0);
            }
        }
    }
#pragma unroll
    for (int qt = 0; qt < 2; ++qt) {
        float lt;
        if (LSUM) lt = OL[qt][0];
        else lt = rows_sum(lrun[qt]);
        const float inv = 1.0f / lt;
        bf16_t* op = Op + (size_t)(w * 32 + qt * 16 + c) * LDO + 4 * g;
#pragma unroll
        for (int dt = 0; dt < DT; ++dt) {
            const f32x4 o = O[dt][qt] * inv;
            u32x2 wv; wv.x = pack2(o[0], o[1]); wv.y = pack2(o[2], o[3]);
            *(u32x2*)(op + dt * 16) = wv;
        }
    }
}

#define HG_BUF 33280
__device__ __forceinline__ unsigned rot16(unsigned x) { return (x >> 16) | (x << 16); }

__device__ __forceinline__ void hgrn_item(const DP& p, int item, bool store_ctx, char* lds, int tid) {
    const int b = item >> 3, h = (item >> 1) & 3, dir = item & 1;
    const int lane = tid & 63, w = tid >> 6, g = lane >> 4, c = lane & 15;
    const bf16_t* HT = (const bf16_t*)(p.ws + OFF_HT) + (size_t)((b * 4 + h) * 4) * 128 * TU;
    const int ch = tid >> 1, half = tid & 1;
    const bf16_t* qrow = HT + (size_t)ch * TU;
    const bf16_t* krow = HT + (size_t)((1 + dir) * 128 + ch) * TU;
    const bf16_t* vrow = HT + (size_t)(3 * 128 + ch) * TU;
    bf16_t* Og = dir ? (bf16_t*)(p.ws + OFF_OHB) + (size_t)b * TU * 512 + h * 128 : (bf16_t*)(p.ws + OFF_P) + (size_t)b * TU * PW + PC_HOH + h * 128;
    const int ldo = dir ? 512 : PW;
    const int pch = (ch & ~31) | (((ch >> 2) & 3) << 3) | (((ch >> 4) & 1) << 2) | (ch & 3);
    const int q_wr = (pch & 7) * 2;
    const int q_chk = pch >> 3;
    const int kh_wr = ch * 64 + 8 * half;
    const int sw = (ch >> 1) & 3;
    int qk_rd[4];
#pragma unroll
    for (int ks = 0; ks < 4; ++ks) qk_rd[ks] = c * 256 + ((ks ^ (c >> 2)) << 6) + ((g ^ (c & 3)) << 4);
    const int kh_rd = 16384 + c * 64 + ((g ^ ((c >> 1) & 3)) << 4);
    const int vt_rd = 24576 + (32 * w + c) * 64 + ((g ^ ((c >> 1) & 3)) << 4);
    const int d_rd = 32768 + 16 * g;

    f32x4 S[8][2];
#pragma unroll
    for (int kt = 0; kt < 8; ++kt) { S[kt][0] = (f32x4){0.f, 0.f, 0.f, 0.f}; S[kt][1] = (f32x4){0.f, 0.f, 0.f, 0.f}; }

    u32x4 lq0, lq1, lk0, lk1, lv0, lv1;
    auto chunk_base = [&](int j) -> int {
        if (!dir) return j < 8 ? SEQ + 32 * j : 32 * (j - 8);
        return j < 8 ? SEQ + CTXL - 32 * (j + 1) : SEQ - 32 * (j - 7);
    };
    auto gload = [&](int j) {
        const int off = chunk_base(j) + (dir ? 16 * (1 - half) : 16 * half);
        lq0 = *(const u32x4*)(qrow + off); lq1 = *(const u32x4*)(qrow + off + 8);
        lk0 = *(const u32x4*)(krow + off); lk1 = *(const u32x4*)(krow + off + 8);
        lv0 = *(const u32x4*)(vrow + off); lv1 = *(const u32x4*)(vrow + off + 8);
    };
    auto prep = [&](char* B) {
        unsigned qw[8] = {lq0.x, lq0.y, lq0.z, lq0.w, lq1.x, lq1.y, lq1.z, lq1.w};
        unsigned kw[8] = {lk0.x, lk0.y, lk0.z, lk0.w, lk1.x, lk1.y, lk1.z, lk1.w};
        unsigned vw[8] = {lv0.x, lv0.y, lv0.z, lv0.w, lv1.x, lv1.y, lv1.z, lv1.w};
        if (dir) {
#pragma unroll
            for (int d = 0; d < 4; ++d) {
                unsigned t0 = rot16(qw[7 - d]); qw[7 - d] = rot16(qw[d]); qw[d] = t0;
                unsigned t1 = rot16(kw[7 - d]); kw[7 - d] = rot16(kw[d]); kw[d] = t1;
                unsigned t2 = rot16(vw[7 - d]); vw[7 - d] = rot16(vw[d]); vw[d] = t2;
            }
        }
        float bc[16]; float run = 0.f;
#pragma unroll
        for (int i = 0; i < 16; ++i) {
            const float kv = (i & 1) ? bfhi(kw[i >> 1]) : bflo(kw[i >> 1]);
            run += fmaxf(__builtin_amdgcn_logf(1.0f - kv), -126.0f);
            bc[i] = run;
        }
        const float oth = __shfl_xor(run, 1);
        const float bend = run + oth;
        const float add = half ? oth : 0.f;
        unsigned khw[8];
#pragma unroll
        for (int i = 0; i < 16; i += 2) {
            float qt[2], kt2[2], kh2[2];
#pragma unroll
            for (int e = 0; e < 2; ++e) {
                const float bb = bc[i + e] + add;
                const float bcl = fmaxf(bb, -120.0f);
                const float qv = e ? bfhi(qw[i >> 1]) : bflo(qw[i >> 1]);
                const float kv = e ? bfhi(kw[i >> 1]) : bflo(kw[i >> 1]);
                qt[e] = qv * __builtin_amdgcn_exp2f(bcl);
                kt2[e] = kv * __builtin_amdgcn_exp2f(-bcl);
                kh2[e] = kv * __builtin_amdgcn_exp2f(bend - bb);
                const int tau = 16 * half + i + e;
                const int a = tau * 256 + ((q_chk ^ (tau & 15)) << 4) + q_wr;
                *(bf16_t*)(B + a) = (bf16_t)f2bf(qt[e]);
                *(bf16_t*)(B + 8192 + a) = (bf16_t)f2bf(kt2[e]);
            }
            khw[i >> 1] = pack2(kh2[0], kh2[1]);
        }
#pragma unroll
        for (int gq = 0; gq < 4; ++gq) {
            u32x2 a; a.x = khw[2 * gq]; a.y = khw[2 * gq + 1];
            *(u32x2*)(B + 16384 + kh_wr + ((gq ^ sw) << 4)) = a;
            u32x2 v2; v2.x = vw[2 * gq]; v2.y = vw[2 * gq + 1];
            *(u32x2*)(B + 24576 + kh_wr + ((gq ^ sw) << 4)) = v2;
        }
        if (half == 0) *(float*)(B + 32768 + ch * 4) = __builtin_amdgcn_exp2f(bend);
    };

    __syncthreads();
    gload(0);
    prep(lds);
    __syncthreads();
    const int NCH = TU / 32;
    for (int j = 0; j < NCH; ++j) {
        const char* B = lds + (j & 1) * HG_BUF;
        if (j + 1 < NCH) gload(j + 1);
        f32x4 a00 = {0.f, 0.f, 0.f, 0.f}, a01 = {0.f, 0.f, 0.f, 0.f}, a11 = {0.f, 0.f, 0.f, 0.f};
        f32x4 o[2][2];
        o[0][0] = o[0][1] = o[1][0] = o[1][1] = (f32x4){0.f, 0.f, 0.f, 0.f};
#pragma unroll
        for (int ks = 0; ks < 4; ++ks) {
            const bf16x8 q0 = *(const bf16x8*)(B + qk_rd[ks]), q1 = *(const bf16x8*)(B + qk_rd[ks] + 4096);
            const bf16x8 k0 = *(const bf16x8*)(B + 8192 + qk_rd[ks]), k1 = *(const bf16x8*)(B + 8192 + qk_rd[ks] + 4096);
            a00 = __builtin_amdgcn_mfma_f32_16x16x32_bf16(k0, q0, a00, 0, 0, 0);
            a01 = __builtin_amdgcn_mfma_f32_16x16x32_bf16(k0, q1, a01, 0, 0, 0);
            a11 = __builtin_amdgcn_mfma_f32_16x16x32_bf16(k1, q1, a11, 0, 0, 0);
#pragma unroll
            for (int nv = 0; nv < 2; ++nv) {
                u32x4 sb;
                sb.x = pack2(S[2 * ks][nv][0], S[2 * ks][nv][1]); sb.y = pack2(S[2 * ks][nv][2], S[2 * ks][nv][3]);
                sb.z = pack2(S[2 * ks + 1][nv][0], S[2 * ks + 1][nv][1]); sb.w = pack2(S[2 * ks + 1][nv][2], S[2 * ks + 1][nv][3]);
                const bf16x8 sbf = __builtin_bit_cast(bf16x8, sb);
                o[0][nv] = __builtin_amdgcn_mfma_f32_16x16x32_bf16(q0, sbf, o[0][nv], 0, 0, 0);
                o[1][nv] = __builtin_amdgcn_mfma_f32_16x16x32_bf16(q1, sbf, o[1][nv], 0, 0, 0);
            }
        }
#pragma unroll
        for (int r = 0; r < 4; ++r) { if (4 * g + r > c) { a00[r] = 0.f; a11[r] = 0.f; } }
        u32x4 pa0, pa1;
        pa0.x = pack2(a00[0], a00[1]); pa0.y = pack2(a00[2], a00[3]); pa0.z = 0u; pa0.w = 0u;
        pa1.x = pack2(a01[0], a01[1]); pa1.y = pack2(a01[2], a01[3]); pa1.z = pack2(a11[0], a11[1]); pa1.w = pack2(a11[2], a11[3]);
        const bf16x8 vt0 = *(const bf16x8*)(B + vt_rd), vt1 = *(const bf16x8*)(B + vt_rd + 1024);
        o[0][0] = __builtin_amdgcn_mfma_f32_16x16x32_bf16(__builtin_bit_cast(bf16x8, pa0), vt0, o[0][0], 0, 0, 0);
        o[0][1] = __builtin_amdgcn_mfma_f32_16x16x32_bf16(__builtin_bit_cast(bf16x8, pa0), vt1, o[0][1], 0, 0, 0);
        o[1][0] = __builtin_amdgcn_mfma_f32_16x16x32_bf16(__builtin_bit_cast(bf16x8, pa1), vt0, o[1][0], 0, 0, 0);
        o[1][1] = __builtin_amdgcn_mfma_f32_16x16x32_bf16(__builtin_bit_cast(bf16x8, pa1), vt1, o[1][1], 0, 0, 0);
#pragma unroll
        for (int kt = 0; kt < 8; ++kt) {
            const f32x4 dv = *(const f32x4*)(B + d_rd + kt * 64);
            const bf16x8 khf = *(const bf16x8*)(B + kh_rd + kt * 1024);
            S[kt][0] = __builtin_amdgcn_mfma_f32_16x16x32_bf16(khf, vt0, S[kt][0] * dv, 0, 0, 0);
            S[kt][1] = __builtin_amdgcn_mfma_f32_16x16x32_bf16(khf, vt1, S[kt][1] * dv, 0, 0, 0);
        }
        {
            const int base = chunk_base(j);
#pragma unroll
            for (int tt = 0; tt < 2; ++tt)
#pragma unroll
                for (int r = 0; r < 4; ++r) {
                    const int tau = 16 * tt + 4 * g + r;
                    const int tok = dir ? base + 31 - tau : base + tau;
                    if (store_ctx || tok < SEQ) {
                        bf16_t* op = Og + (size_t)tok * ldo + 32 * w + c;
                        op[0] = (bf16_t)f2bf(o[tt][0][r]);
                        op[16] = (bf16_t)f2bf(o[tt][1][r]);
                    }
                }
        }
        if (j + 1 < NCH) prep(lds + ((j + 1) & 1) * HG_BUF);
        __syncthreads();
    }
}

#define QCTR_WORD(l) (3520 + 64 * (l))
__device__ __forceinline__ void phase_mixers(const DP& p, int l, char* lds, int tid, int mask) {
    const int nqb = (l == 0) ? 18 : 16;
    const int nBi = NB * 4 * nqb, nAi = NB * 8 * nqb, nDi = NB * 8 * nqb;
    if (mask & 1) for (int it = p.bid; it < 64; it += p.nblk) hgrn_item(p, it, l == 0, lds, tid);
    if (mask & 14) {
        unsigned* ctr = (unsigned*)(p.ws + OFF_BAR) + QCTR_WORD(l) + (mask == 15 ? 0 : 16);
        volatile int* slot = (volatile int*)(lds + LDS_MISC + 992);
        for (;;) {
            __syncthreads();
            if (tid == 0) *slot = (int)atomicAdd(ctr, 1u);
            __syncthreads();
            int it = *slot;
            int tl = tid;
            asm volatile("" : "+v"(tl));
            if (mask != 15) { if (!(mask & 2)) it += nBi; if (it >= nBi && !(mask & 4)) it = nBi + nAi + nDi; if (!(mask & 8) && it >= nBi + nAi) it = nBi + nAi + nDi; }
            if (it >= nBi + nAi + nDi) break;
            if (it < nBi) {
                const int j = it;
                const int qb = j % nqb, h = (j / nqb) & 3, b = j / (nqb * 4);
                const int tok0 = qb < 16 ? qb * 128 : SEQ + (qb - 16) * 128;
                const size_t rowq = (size_t)b * TU + tok0;
                attn_item<192, 128, BKT, false, 768, 768, 512>((const bf16_t*)(p.ws + OFF_QB) + rowq * 768 + h * 192,
                                           (const bf16_t*)(p.ws + OFF_KB) + (size_t)b * TU * 768 + h * 192,
                                           (const bf16_t*)(p.ws + OFF_VTB) + (size_t)(b * 4 + h) * 128 * TU,
                                           (bf16_t*)(p.ws + OFF_OB) + rowq * 512 + h * 128,
                                           0, 0, qb < 16 ? 0 : SEQ, (qb < 16 ? TU : CTXL) / BKT, 0, -1e30f, 0.f, lds, tl);
            } else if (it < nBi + nAi) {
                const int j = it - nBi;
                const bf16_t* P = (const bf16_t*)(p.ws + OFF_P);
                const int qb = j % nqb, hs = (j / nqb) & 7, b = j / (nqb * 8);
                const int h = hs >> 1, sidx = hs & 1;
                const int tok0 = qb < 16 ? qb * 128 : SEQ + (qb - 16) * 128;
                const size_t rowq = (size_t)b * TU + tok0;
                attn_item<64, 128, 64, false, PW, PW, 1024>(P + rowq * PW + PC_AQ + h * 128 + sidx * 64,
                                          P + (size_t)b * TU * PW + (sidx ? PC_AK2 : PC_AK1) + h * 64,
                                          (const bf16_t*)(p.ws + OFF_VTA) + (size_t)(b * 4 + h) * 128 * TU,
                                          (bf16_t*)(p.ws + OFF_OA12) + rowq * 1024 + hs * 128,
                                          0, 0, qb < 16 ? 0 : SEQ, qb < 16 ? 36 : 4, 0, -1e30f, 0.f, lds, tl);
            } else {
                const int j = it - nBi - nAi;
                const bf16_t* P = (const bf16_t*)(p.ws + OFF_P);
                const int qb = j % nqb, hq = (j / nqb) & 7, b = j / (nqb * 8);
                const int tok0 = qb < 16 ? qb * 128 : SEQ + (qb - 16) * 128;
                const size_t rowq = (size_t)b * TU + tok0;
                int s0 = 0, n0 = 0;
                if (qb < 16) { s0 = qb * 128 - 128; if (s0 < 0) s0 = 0; int e0 = qb * 128 + 256; if (e0 > SEQ) e0 = SEQ; n0 = (e0 - s0) >> 6; }
                const float sink = p.in[I_SINK][l * 8 + hq] * LOG2E;
                bf16_t* qo = (bf16_t*)(p.ws + OFF_P) + rowq * PW + PC_DQ + hq * 64;
                attn_item<64, 64, 64, true, PW, PW, PW>(qo, P + (size_t)b * TU * PW + PC_DK + (hq >> 2) * 64,
                                        (const bf16_t*)(p.ws + OFF_VTD) + (size_t)(b * 2 + (hq >> 2)) * 64 * TU,
                                        qo, s0, n0, SEQ, 4, tok0, sink, 1.0f, lds, tl);
            }
        }
    }
}

__device__ __forceinline__ void phase_convq(const DP& p, int l, char* lds, int tid) {
    unsigned* ctr2 = (unsigned*)(p.ws + OFF_BAR) + QCTR_WORD(l) + 32;
    volatile int* slot = (volatile int*)(lds + LDS_MISC + 992);
    for (;;) {
        __syncthreads();
        if (tid == 0) *slot = (int)atomicAdd(ctr2, 1u);
        __syncthreads();
        const int it = *slot;
        if (it >= NCONV) break;
        int tl = tid;
        asm volatile("" : "+v"(tl));
        conv_tables_item(p, l, it, tl);
    }
}

__device__ __forceinline__ void phase_combine(const DP& p, int l, int tid) {
    const int lane = tid & 63;
    const int gw = p.bid * 4 + (tid >> 6), nw = p.nblk * 4;
    const float lam = ((const float*)(p.ws + OFF_LAM))[l * 2 + 0], lam_init = ((const float*)(p.ws + OFF_LAM))[l * 2 + 1];
    const int h = lane >> 4, d0 = (lane & 15) * 8;
    const float* dng = p.in[I_DNG] + l * 128 + d0;
    const float* hng = p.in[I_HNG] + l * 128 + d0;
    bf16_t* P = (bf16_t*)(p.ws + OFF_P);
    const bf16_t* OA = (const bf16_t*)(p.ws + OFF_OA12);
    const bf16_t* OBk = (const bf16_t*)(p.ws + OFF_OHB);
    for (int row = gw; row < RR; row += nw) {
        const int t = row % TU;
        if (l == 1 && t >= SEQ) continue;
        {
            const u32x4 a = *(const u32x4*)(OA + (size_t)row * 1024 + (h * 2 + 0) * 128 + d0);
            const u32x4 bq = *(const u32x4*)(OA + (size_t)row * 1024 + (h * 2 + 1) * 128 + d0);
            float o[8]; float ss = 0.f;
#pragma unroll
            for (int i = 0; i < 4; ++i) { o[2 * i] = bflo(a[i]) - lam * bflo(bq[i]); o[2 * i + 1] = bfhi(a[i]) - lam * bfhi(bq[i]); }
#pragma unroll
            for (int i = 0; i < 8; ++i) ss += o[i] * o[i];
            ss += __shfl_xor(ss, 1); ss += __shfl_xor(ss, 2); ss += __shfl_xor(ss, 4); ss += __shfl_xor(ss, 8);
            const float rstd = rsqrtf(ss * (1.0f / 128.0f) + 1e-6f) * (1.0f - lam_init);
            u32x4 w;
            w.x = pack2(o[0] * rstd * dng[0], o[1] * rstd * dng[1]); w.y = pack2(o[2] * rstd * dng[2], o[3] * rstd * dng[3]);
            w.z = pack2(o[4] * rstd * dng[4], o[5] * rstd * dng[5]); w.w = pack2(o[6] * rstd * dng[6], o[7] * rstd * dng[7]);
            *(u32x4*)(P + (size_t)row * PW + PC_AQ + h * 128 + d0) = w;
        }
        {
            const u32x4 a = *(const u32x4*)(P + (size_t)row * PW + PC_HOH + h * 128 + d0);
            const u32x4 bq = *(const u32x4*)(OBk + (size_t)row * 512 + h * 128 + d0);
            const u32x4 gg = *(const u32x4*)(P + (size_t)row * PW + PC_HG + h * 128 + d0);
            float o[8], gt[8]; float ss = 0.f;
#pragma unroll
            for (int i = 0; i < 4; ++i) { o[2 * i] = bflo(a[i]) + bflo(bq[i]); o[2 * i + 1] = bfhi(a[i]) + bfhi(bq[i]); gt[2 * i] = bflo(gg[i]); gt[2 * i + 1] = bfhi(gg[i]); }
#pragma unroll
            for (int i = 0; i < 8; ++i) ss += o[i] * o[i];
            ss += __shfl_xor(ss, 1); ss += __shfl_xor(ss, 2); ss += __shfl_xor(ss, 4); ss += __shfl_xor(ss, 8);
            const float rstd = rsqrtf(ss * (1.0f / 128.0f) + 1e-6f);
            float y[8];
#pragma unroll
            for (int i = 0; i < 8; ++i) y[i] = o[i] * rstd * hng[i] * siluf_(gt[i]);
            u32x4 w; w.x = pack2(y[0], y[1]); w.y = pack2(y[2], y[3]); w.z = pack2(y[4], y[5]); w.w = pack2(y[6], y[7]);
            *(u32x4*)(P + (size_t)row * PW + PC_HOH + h * 128 + d0) = w;
        }
    }
}

__device__ __forceinline__ void merge_branch_src(const DP& p, int j, int row0, const bf16_t*& A, int& lda) {
    const bf16_t* P = (const bf16_t*)(p.ws + OFF_P);
    if (j == 0) { A = P + (size_t)row0 * PW + PC_AQ; lda = PW; }
    else if (j == 1) { A = (const bf16_t*)(p.ws + OFF_OB) + (size_t)row0 * 512; lda = 512; }
    else if (j == 2) { A = P + (size_t)row0 * PW + PC_HOH; lda = PW; }
    else { A = P + (size_t)row0 * PW + PC_DQ; lda = PW; }
}
__device__ __forceinline__ void phase_merge(const DP& p, int l, char* lds, int tid) {
    const int lane = tid & 63, wid = tid >> 6, wr = wid >> 1, wc = wid & 1, g = lane >> 4, c = lane & 15;
    const bf16_t* HX = (const bf16_t*)(p.ws + OFF_HX);
    bf16_t* Y = (bf16_t*)(p.ws + OFF_Y);
    const bf16_t* WG = (const bf16_t*)(p.ws + OFF_WG);
    const bf16_t* WBR = (const bf16_t*)(p.ws + OFF_WBR);
    TileIter ti;
    if (l == DEPTH_ - 1) ti.init(p, 8, 4, 128); else ti.init(p, 8, 6);
    int tm, tn, tmn, tnn;
    bool have = false, haven = false;
    auto fetch = [&](int& a_tm, int& a_tn) -> bool { if (!ti.next(a_tm, a_tn)) return false; if (l == DEPTH_ - 1) a_tm = (a_tm >> 4) * 18 + (a_tm & 15); return true; };
    have = fetch(tm, tn);
    int par = 0; bool pre = false;
    while (have) {
        haven = fetch(tmn, tnn);
        const int row0 = tm * 128, col0 = tn * 128;
        u32x2 y[4][4];
#pragma unroll
        for (int m = 0; m < 4; ++m)
#pragma unroll
            for (int n = 0; n < 4; ++n) { y[m][n].x = 0u; y[m][n].y = 0u; }
#pragma unroll 1
        for (int j = 0; j < 4; ++j) {
            const bf16_t* Ab; int ldab; merge_branch_src(p, j, row0, Ab, ldab);
            const bf16_t* Bb = WBR + (size_t)j * 1024 * 512 + (size_t)col0 * 512;
            u32x2 sg[4][4];
            {
                f32x4 ag[4][4]; zero_acc<4, 4>(ag);
                gemm_core<128, true>(HX + (size_t)row0 * DM, DM, WG + (size_t)(j * 1024 + col0) * DM, DM, DM, ag, lds, tid, par, pre, Ab, ldab, Bb, 512);
#pragma unroll
                for (int m = 0; m < 4; ++m)
#pragma unroll
                    for (int n = 0; n < 4; ++n) {
                        float sv[4];
#pragma unroll
                        for (int r = 0; r < 4; ++r) sv[r] = 1.0f / (1.0f + __expf(-ag[m][n][r]));
                        sg[m][n].x = pack2(sv[0], sv[1]); sg[m][n].y = pack2(sv[2], sv[3]);
                    }
            }
            const bf16_t* An = nullptr; const bf16_t* Bn = nullptr;
            if (j < 3) { An = HX + (size_t)row0 * DM; Bn = WG + (size_t)((j + 1) * 1024 + col0) * DM; }
            else if (haven) { An = HX + (size_t)(tmn * 128) * DM; Bn = WG + (size_t)(tnn * 128) * DM; }
            f32x4 ab[4][4]; zero_acc<4, 4>(ab);
            gemm_core<128, true>(Ab, ldab, Bb, 512, 512, ab, lds, tid, par, true, An, DM, Bn, DM);
            pre = (An != nullptr);
#pragma unroll
            for (int m = 0; m < 4; ++m)
#pragma unroll
                for (int n = 0; n < 4; ++n) {
                    const float y0 = bflo(y[m][n].x) + ab[m][n][0] * bflo(sg[m][n].x), y1 = bfhi(y[m][n].x) + ab[m][n][1] * bfhi(sg[m][n].x);
                    const float y2 = bflo(y[m][n].y) + ab[m][n][2] * bflo(sg[m][n].y), y3 = bfhi(y[m][n].y) + ab[m][n][3] * bfhi(sg[m][n].y);
                    y[m][n].x = pack2(y0, y1); y[m][n].y = pack2(y2, y3);
                }
        }
#pragma unroll
        for (int m = 0; m < 4; ++m) {
            const int row = row0 + wr * 64 + m * 16 + c;
#pragma unroll
            for (int n = 0; n < 4; ++n)
                *(u32x2*)(Y + (size_t)row * DM + col0 + wc * 64 + n * 16 + 4 * g) = y[m][n];
        }
        have = haven; tm = tmn; tn = tnn;
    }
}

__device__ __forceinline__ void phase_wout(const DP& p, int l, char* lds, int tid) {
    const int lane = tid & 63, wid = tid >> 6, wr = wid >> 1, wc = wid & 1, g = lane >> 4, c = lane & 15;
    const bf16_t* Y = (const bf16_t*)(p.ws + OFF_Y);
    float* X = (float*)(p.ws + OFF_X);
    const float* mod = (const float*)(p.ws + OFF_MOD) + (size_t)l * 9 * 6144;
    TileIter ti;
    if (l == DEPTH_ - 1) ti.init(p, 8, 8, 64); else ti.init(p, 8, 9, 72);
    int tm, tn;
    while (ti.next(tm, tn)) {
        if (l == DEPTH_ - 1) tm = (tm >> 3) * 9 + (tm & 7);
        const int row0 = tm * 256, col0 = tn * 128;
        const bool isctx = (tm % 9) == 8;
        f32x4 acc[8][4]; zero_acc<8, 4>(acc);
        gemm256<true>(Y + (size_t)row0 * DM, DM, (const bf16_t*)(p.ws + OFF_WOUT) + (size_t)col0 * DM, DM, DM, acc, lds, tid);
        const float* gate = mod + (isctx ? 8 : (tm / 9)) * 6144 + 2 * 1024;
#pragma unroll
        for (int m = 0; m < 8; ++m) {
            const int row = row0 + wr * 128 + m * 16 + c;
#pragma unroll
            for (int n = 0; n < 4; ++n) {
                const int col = col0 + wc * 64 + n * 16 + 4 * g;
                const f32x4 gt = *(const f32x4*)(gate + col);
                f32x4* xp = (f32x4*)(X + (size_t)row * DM + col);
                *xp = *xp + gt * acc[m][n];
            }
        }
    }
}

__device__ __forceinline__ void phase_peerq(const DP& p, int l, char* lds, int tid) {
    const int lane = tid & 63, wid = tid >> 6, wr = wid >> 1, wc = wid & 1, g = lane >> 4, c = lane & 15;
    const bf16_t* HX = (const bf16_t*)(p.ws + OFF_HX);
    bf16_t* PQ = (bf16_t*)(p.ws + OFF_PQ);
    TileIter ti;
    if (l == DEPTH_ - 1) ti.init(p, 8, 8, 64); else ti.init(p, 8, 9, 72);
    int tm, tn;
    while (ti.next(tm, tn)) {
        if (l == DEPTH_ - 1) tm = (tm >> 3) * 9 + (tm & 7);
        const int row0 = tm * 256, col0 = tn * 128;
        f32x4 acc[8][4]; zero_acc<8, 4>(acc);
        gemm256<true>(HX + (size_t)row0 * DM, DM, (const bf16_t*)(p.ws + OFF_WPQ) + (size_t)col0 * DM, DM, DM, acc, lds, tid);
#pragma unroll
        for (int m = 0; m < 8; ++m) {
            const int row = row0 + wr * 128 + m * 16 + c;
#pragma unroll
            for (int n = 0; n < 4; ++n) {
                u32x2 w; w.x = pack2(acc[m][n][0], acc[m][n][1]); w.y = pack2(acc[m][n][2], acc[m][n][3]);
                *(u32x2*)(PQ + (size_t)row * DM + col0 + wc * 64 + n * 16 + 4 * g) = w;
            }
        }
    }
}

__device__ __forceinline__ unsigned ord_key(float f) { const unsigned u = __float_as_uint(f); return (u & 0x80000000u) ? ~u : (u | 0x80000000u); }
__device__ __forceinline__ float ord_val(unsigned k) { const unsigned u = (k & 0x80000000u) ? (k & 0x7fffffffu) : ~k; return __uint_as_float(u); }
template <int CTRL> __device__ __forceinline__ unsigned dpp_u(unsigned x) { return (unsigned)__builtin_amdgcn_mov_dpp((int)x, CTRL, 0xf, 0xf, true); }
template <int CTRL> __device__ __forceinline__ float dpp_f(float x) { return __builtin_bit_cast(float, __builtin_amdgcn_mov_dpp(__builtin_bit_cast(int, x), CTRL, 0xf, 0xf, true)); }
__device__ __forceinline__ unsigned row_max_u32(unsigned v) {
    v = max(v, dpp_u<0xB1>(v)); v = max(v, dpp_u<0x4E>(v)); v = max(v, dpp_u<0x141>(v)); v = max(v, dpp_u<0x128>(v));
    return v;
}
__device__ __forceinline__ float row_sum_f32(float v) {
    v += dpp_f<0xB1>(v); v += dpp_f<0x4E>(v); v += dpp_f<0x141>(v); v += dpp_f<0x128>(v);
    return v;
}

template <int NR>
__device__ __forceinline__ void peer_topk(unsigned (&sk)[NR][2][8], int lane, int c, int* pi, float* pg, int pstride) {
    unsigned mine[NR][2];
#pragma unroll
    for (int r = 0; r < NR; ++r) { mine[r][0] = 0u; mine[r][1] = 0u; }
#pragma unroll 1
    for (int rnd = 0; rnd < 16; ++rnd) {
#pragma unroll
        for (int r = 0; r < NR; ++r)
#pragma unroll
            for (int pp = 0; pp < 2; ++pp) {
                unsigned m = sk[r][pp][0];
#pragma unroll
                for (int nf = 1; nf < 8; ++nf) m = max(m, sk[r][pp][nf]);
                m = row_max_u32(m);
#pragma unroll
                for (int nf = 0; nf < 8; ++nf) sk[r][pp][nf] = (sk[r][pp][nf] == m) ? 0u : sk[r][pp][nf];
                if (c == rnd) mine[r][pp] = m;
            }
    }
    float sv[NR][2]; int si[NR][2];
#pragma unroll
    for (int r = 0; r < NR; ++r)
#pragma unroll
        for (int pp = 0; pp < 2; ++pp) { sv[r][pp] = ord_val(mine[r][pp] & ~127u); si[r][pp] = 127 - (int)(mine[r][pp] & 127u); }
    int ptr[NR]; unsigned minec[NR];
#pragma unroll
    for (int r = 0; r < NR; ++r) { ptr[r] = 0; minec[r] = 0u; }
#pragma unroll 1
    for (int rnd = 0; rnd < 16; ++rnd) {
#pragma unroll
        for (int r = 0; r < NR; ++r) {
            const float s0 = __shfl(sv[r][0], (lane & 48) | (ptr[r] & 15));
            const float cv = s0 + sv[r][1];
            unsigned key = (ptr[r] < 16) ? ((ord_key(cv) & ~255u) | (unsigned)(255 - (ptr[r] * 16 + c))) : 0u;
            const unsigned m = row_max_u32(key);
            if (key == m) ptr[r]++;
            if (c == rnd) minec[r] = m;
        }
    }
#pragma unroll
    for (int r = 0; r < NR; ++r) {
        const int flat = 255 - (int)(minec[r] & 255u);
        const int ei = flat >> 4, ej = flat & 15;
        const float tsv = __shfl(sv[r][0], (lane & 48) | ei) + __shfl(sv[r][1], (lane & 48) | ej);
        const int eidx = __shfl(si[r][0], (lane & 48) | ei) * 128 + __shfl(si[r][1], (lane & 48) | ej);
        const float tmax = ord_val(row_max_u32(ord_key(tsv)));
        const float ex = __expf(tsv - tmax);
        pi[r * pstride] = eidx;
        pg[r * pstride] = ex / row_sum_f32(ex);
    }
}

template <bool nostore, bool Q>
__device__ __forceinline__ void peer_item(const DP& p, int l, char* lds, int tid, int row0) {
    typedef float f32x2 __attribute__((ext_vector_type(2)));
    typedef unsigned v6u __attribute__((ext_vector_type(6)));
    typedef float v32f __attribute__((ext_vector_type(32)));
    const int wid = tid >> 6;
    const bf16_t* H2 = (const bf16_t*)(p.ws + OFF_HX);
    const bf16_t* PQ = (const bf16_t*)(p.ws + OFF_PQ);
    const bf16_t* KEYS = (const bf16_t*)(p.ws + KEYS_OFF(l));
    const unsigned char* TUu = (const unsigned char*)(p.ws + OFF_TU);
    const unsigned char* TVv = (const unsigned char*)(p.ws + OFF_TV);
    const float* SUs = (const float*)(p.ws + OFF_SU);
    const float* SVs = (const float*)(p.ws + OFF_SV);
    float* X = (float*)(p.ws + OFF_X);
    const float* mod = (const float*)(p.ws + OFF_MOD) + (size_t)l * 9 * 6144;
    int* park_i = (int*)lds;
    float* park_g = (float*)(lds + 8192);
    {
        int lane = tid & 63;
        asm volatile("" : "+v"(lane));
        const int g = lane >> 4, c = lane & 15;
#pragma unroll 1
        for (int hh = 0; hh < 2; ++hh) {
            const int h = wid * 2 + hh;
            int cl = c, gl = g;
            asm volatile("" : "+v"(cl)); asm volatile("" : "+v"(gl));
            f32x4 sacc[2][8];
#pragma unroll
            for (int pp = 0; pp < 2; ++pp) {
#pragma unroll
                for (int nf = 0; nf < 8; ++nf) sacc[pp][nf] = (f32x4){0.f, 0.f, 0.f, 0.f};
#pragma unroll
                for (int ks = 0; ks < 2; ++ks) {
                    const bf16x8 af = *(const bf16x8*)(PQ + (size_t)(row0 + (Q ? (cl >> 2) : cl)) * DM + (h * 2 + pp) * 64 + ks * 32 + 8 * gl);
#pragma unroll
                    for (int nf = 0; nf < 8; ++nf) {
                        const bf16x8 bfr = *(const bf16x8*)(KEYS + (size_t)((h * 2 + pp) * 128 + nf * 16 + cl) * 64 + ks * 32 + 8 * gl);
                        sacc[pp][nf] = __builtin_amdgcn_mfma_f32_16x16x32_bf16(af, bfr, sacc[pp][nf], 0, 0, 0);
                    }
                }
            }
            {
                constexpr int NR = Q ? 1 : 4;
                unsigned sk[NR][2][8];
#pragma unroll
                for (int r = 0; r < NR; ++r)
#pragma unroll
                    for (int pp = 0; pp < 2; ++pp)
#pragma unroll
                        for (int nf = 0; nf < 8; ++nf) sk[r][pp][nf] = (ord_key(sacc[pp][nf][r]) & ~127u) | (unsigned)(127 - (nf * 16 + c));
                const int pidx = (h * 16 + (Q ? g : 4 * g)) * 16 + c;
                peer_topk<NR>(sk, lane, c, park_i + pidx, park_g + pidx, 16);
            }
        }
        __syncthreads();
        const int ts = Q ? wid : 4 * wid + g;
        const int row = row0 + ts;
        const int bb = row / TU, tt = row - bb * TU;
        const int pb0 = ts * 16;
        constexpr int NG = (Q ? 16 : 64) * 2 / EB;
#define PEER_HD(G_) (Q ? 2 * g + ((G_) >> 3) : ((G_) >> 3))
#define PEER_GC(G_) ((G_) < NG ? (G_) : NG - 1)
#define PEER_IDS(ids_, G_) { _Pragma("unroll") for (int r = 0; r < EB; ++r) \
                ids_[r] = park_i[PEER_HD(PEER_GC(G_)) * 256 + pb0 + (PEER_GC(G_) & 7) * EB + r] & ((FAKEIDX && nostore) ? FAKEIDX : 0xffffff); }
#define PEER_WTS(w_, G_) { _Pragma("unroll") for (int r = 0; r < EB; ++r) w_[r] = park_g[PEER_HD(PEER_GC(G_)) * 256 + pb0 + (PEER_GC(G_) & 7) * EB + r]; }
#define PEER_ROWS(T_, buf_, ids_) { \
            _Pragma("unroll") for (int r = 0; r < EB; ++r) { \
                const unsigned char* rp_ = T_ + (size_t)ids_[r] * TROW + c * 16; \
                _Pragma("unroll") for (int j = 0; j < 3; ++j) buf_[r][j] = *(const u32x4*)(rp_ + j * 256); } }
#define PEER_GQ(buf_, r_, k_) v6u gq; \
            if (k_ == 0) { gq[0] = buf_[r_][0][0]; gq[1] = buf_[r_][0][1]; gq[2] = buf_[r_][0][2]; gq[3] = buf_[r_][0][3]; gq[4] = buf_[r_][1][0]; gq[5] = buf_[r_][1][1]; } \
            else         { gq[0] = buf_[r_][1][2]; gq[1] = buf_[r_][1][3]; gq[2] = buf_[r_][2][0]; gq[3] = buf_[r_][2][1]; gq[4] = buf_[r_][2][2]; gq[5] = buf_[r_][2][3]; }
        {
            f32x2 hf2[32];
#pragma unroll
            for (int j = 0; j < 4; ++j) {
                const u32x4 a = *(const u32x4*)(H2 + (size_t)row * DM + j * 256 + c * 16), bq = *(const u32x4*)(H2 + (size_t)row * DM + j * 256 + c * 16 + 8);
#pragma unroll
                for (int q = 0; q < 4; ++q) { hf2[j * 8 + q] = (f32x2){bflo(a[q]), bfhi(a[q])}; hf2[j * 8 + 4 + q] = (f32x2){bflo(bq[q]), bfhi(bq[q])}; }
            }
            float myw = 0.f;
            u32x4 ua[2][EB][3];
#define PEER_UCOMP(buf_, G_) { \
            f32x2 d2[EB], e2[EB]; \
            _Pragma("unroll") for (int r = 0; r < EB; ++r) { d2[r] = (f32x2){0.f, 0.f}; e2[r] = (f32x2){0.f, 0.f}; } \
            _Pragma("unroll") for (int k = 0; k < 2; ++k) { \
                _Pragma("unroll") for (int r = 0; r < EB; ++r) { \
                    PEER_GQ(buf_, r, k) \
                    asm volatile("" : "+v"(gq[0]) : "v"(d2[(r + EB - 1) % EB])); \
                    v32f dv; \
                    if (NODEC && nostore) { _Pragma("unroll") for (int i = 0; i < 32; ++i) dv[i] = __uint_as_float(gq[i % 6]); } \
                    else dv = __builtin_amdgcn_cvt_scalef32_pk32_f32_fp6(gq, 1.0f); \
                    _Pragma("unroll") for (int i = 0; i < 16; i += 2) { \
                        d2[r] = __builtin_elementwise_fma((f32x2){dv[2 * i], dv[2 * i + 1]}, hf2[k * 16 + i], d2[r]); \
                        e2[r] = __builtin_elementwise_fma((f32x2){dv[2 * i + 2], dv[2 * i + 3]}, hf2[k * 16 + i + 1], e2[r]); } \
                    __builtin_amdgcn_sched_barrier(0); } } \
            _Pragma("unroll") for (int r = 0; r < EB; ++r) { \
                const float dd = row_sum_f32((d2[r].x + d2[r].y) + (e2[r].x + e2[r].y)); \
                if (c == ((G_) & 7) * EB + r) myw = dd; } \
            if (((G_) & 7) == 7) {                            \
                const int pi_ = PEER_HD(G_) * 256 + pb0 + c; \
                const int eidx = park_i[pi_]; \
                const float x_ = myw * SUs[eidx]; \
                const float act = 0.5f * x_ * (1.0f + erff(x_ * 0.70710678118654752f)); \
                park_g[pi_] = park_g[pi_] * act * SVs[eidx]; } }
            int idA[EB], idB[EB];
            PEER_IDS(idA, 0); PEER_ROWS(TUu, ua[0], idA); PEER_IDS(idB, 1);
#pragma unroll 1
            for (int G = 0; G < NG; G += 2) {
                PEER_ROWS(TUu, ua[1], idB); PEER_IDS(idA, G + 2);
                __builtin_amdgcn_sched_barrier(0);
                PEER_UCOMP(ua[0], G);
                __builtin_amdgcn_sched_barrier(0);
                PEER_ROWS(TUu, ua[0], idA);
                PEER_IDS(idB, G + 3);
                __builtin_amdgcn_sched_barrier(0);
                PEER_UCOMP(ua[1], G + 1);
                __builtin_amdgcn_sched_barrier(0);
            }
#undef PEER_UCOMP
        }
        float outv[64];
#pragma unroll
        for (int i = 0; i < 64; ++i) outv[i] = 0.f;
        {
            u32x4 va[2][EB][3];
#define PEER_VCOMP(buf_, wr) { \
            _Pragma("unroll") for (int k = 0; k < 2; ++k) { \
                _Pragma("unroll") for (int r = 0; r < EB; ++r) { \
                    PEER_GQ(buf_, r, k) \
                    asm volatile("" : "+v"(gq[0]) : "v"(outv[k * 32 + 31])); \
                    v32f dv; \
                    if (NODEC && nostore) { _Pragma("unroll") for (int i = 0; i < 32; ++i) dv[i] = __uint_as_float(gq[i % 6]); } \
                    else dv = __builtin_amdgcn_cvt_scalef32_pk32_f32_fp6(gq, 1.0f); \
                    _Pragma("unroll") for (int i = 0; i < 32; ++i) outv[k * 32 + i] += wr[r] * dv[i]; \
                    __builtin_amdgcn_sched_barrier(0); } } }
            int idA[EB], idB[EB]; float w0[EB], w1[EB];
            PEER_IDS(idA, 0); PEER_ROWS(TVv, va[0], idA); PEER_IDS(idB, 1); PEER_WTS(w0, 0);
#pragma unroll 1
            for (int G = 0; G < NG; G += 2) {
                PEER_ROWS(TVv, va[1], idB); PEER_IDS(idA, G + 2); PEER_WTS(w1, G + 1);
                __builtin_amdgcn_sched_barrier(0);
                PEER_VCOMP(va[0], w0);
                __builtin_amdgcn_sched_barrier(0);
                if (G + 2 < NG) PEER_ROWS(TVv, va[0], idA);
                PEER_IDS(idB, G + 3); PEER_WTS(w0, G + 2);
                __builtin_amdgcn_sched_barrier(0);
                PEER_VCOMP(va[1], w1);
                __builtin_amdgcn_sched_barrier(0);
            }
#undef PEER_VCOMP
        }
#undef PEER_ROWS
#undef PEER_IDS
#undef PEER_WTS
#undef PEER_GC
#undef PEER_GQ
#undef PEER_HD
        if (Q) {
#pragma unroll
            for (int i = 0; i < 64; ++i) { outv[i] += __shfl_xor(outv[i], 16); outv[i] += __shfl_xor(outv[i], 32); }
        }
        if (nostore) {
#pragma unroll
            for (int i = 0; i < 64; ++i) asm volatile("" :: "v"(outv[i]));
        } else {
            const float* gate = mod + (tt >= SEQ ? 8 : bb) * 6144 + 5 * 1024;
            int rowl = row;
            asm volatile("" : "+v"(rowl));
            float ss = 0.f;
#pragma unroll
            for (int j = 0; j < 4; ++j) {
#pragma unroll
                for (int q = 0; q < 4; ++q) {
                    const int col = j * 256 + c * 16 + 4 * q;
                    const f32x4 g0 = *(const f32x4*)(gate + col);
                    f32x4* xp = (f32x4*)(X + (size_t)rowl * DM + col);
                    f32x4 x0 = *xp;
#pragma unroll
                    for (int i = 0; i < 4; ++i) { x0[i] += g0[i] * outv[j * 16 + 4 * q + i]; outv[j * 16 + 4 * q + i] = x0[i]; ss += x0[i] * x0[i]; }
                    if (l != DEPTH_ - 1 && (!Q || j == g)) *xp = x0;
                }
                __builtin_amdgcn_sched_barrier(0);
            }
            if (l != DEPTH_ - 1) {
                const float rstd = rsqrtf(row_sum_f32(ss) * (1.0f / 1024.0f) + 1e-6f);
                const float* gvec = p.in[I_N1G] + (l + 1) * DM;
                const float* mrow = mod + 9 * 6144 + (tt >= SEQ ? 8 : bb) * 6144;
                bf16_t* hrow = (bf16_t*)(p.ws + OFF_HX) + (size_t)row * DM;
#pragma unroll
                for (int j = 0; j < 4; ++j) {
                    if (!Q || j == g) {
#pragma unroll
                        for (int q = 0; q < 4; ++q) {
                            const int col = j * 256 + c * 16 + 4 * q;
                            const f32x4 g4 = *(const f32x4*)(gvec + col);
                            const f32x4 sh = *(const f32x4*)(mrow + col);
                            const f32x4 sc = *(const f32x4*)(mrow + 1024 + col);
                            float y[4];
#pragma unroll
                            for (int i = 0; i < 4; ++i) y[i] = outv[j * 16 + 4 * q + i] * rstd * g4[i] * (1.0f + sc[i]) + sh[i];
                            u32x2 w; w.x = pack2(y[0], y[1]); w.y = pack2(y[2], y[3]);
                            *(u32x2*)(hrow + col) = w;
                        }
                    }
                    __builtin_amdgcn_sched_barrier(0);
                }
            }
            if (l == DEPTH_ - 1) {
                const float rstd = rsqrtf(row_sum_f32(ss) * (1.0f / 1024.0f) + 1e-6f);
                const float* fg = p.in[I_FG];
                float* orow = p.out + (size_t)(bb * SEQ + tt) * DM;
#pragma unroll
                for (int j = 0; j < 4; ++j) {
                    if (!Q || j == g) {
#pragma unroll
                        for (int q = 0; q < 4; ++q) {
                            const int col = j * 256 + c * 16 + 4 * q;
                            const f32x4 f4 = *(const f32x4*)(fg + col);
                            f32x4 o4;
#pragma unroll
                            for (int i = 0; i < 4; ++i) o4[i] = outv[j * 16 + 4 * q + i] * rstd * f4[i];
                            *(f32x4*)(orow + col) = o4;
                        }
                    }
                    __builtin_amdgcn_sched_barrier(0);
                }
            }
        }
        __syncthreads();
    }
}

template <bool nostore>
__device__ __forceinline__ void phase_peer(const DP& p, int l, char* lds, int tid) {
    const int nbi = (l == 0) ? RR / 16 : NB * SEQ / 16;
    const int nfull = (nbi / p.nblk) * p.nblk;
    for (int bi = p.bid; bi < nfull; bi += p.nblk) {
        int row0;
        if (l == 0) row0 = bi * 16; else { const int b = bi / (SEQ / 16); row0 = b * TU + (bi % (SEQ / 16)) * 16; }
        peer_item<nostore, false>(p, l, lds, tid, row0);
    }
    for (int qi = p.bid; qi < (nbi - nfull) * 4; qi += p.nblk) {
        const int bi = nfull + (qi >> 2);
        int row0;
        if (l == 0) row0 = bi * 16; else { const int b = bi / (SEQ / 16); row0 = b * TU + (bi % (SEQ / 16)) * 16; }
        peer_item<nostore, true>(p, l, lds, tid, row0 + (qi & 3) * 4);
    }
}

__device__ __forceinline__ void phase_final(const DP& p, int tid) {
    const int lane = tid & 63;
    const int gw = p.bid * 4 + (tid >> 6), nw = p.nblk * 4;
    const float* X = (const float*)(p.ws + OFF_X);
    const float* fg = p.in[I_FG];
    for (int r = gw; r < NB * SEQ; r += nw) {
        const int b = r / SEQ, t = r - b * SEQ;
        const float* src = X + (size_t)(b * TU + t) * DM;
        f32x4 v[4]; float ss = 0.f;
#pragma unroll
        for (int j = 0; j < 4; ++j) { v[j] = *(const f32x4*)(src + j * 256 + lane * 4); ss += v[j][0] * v[j][0] + v[j][1] * v[j][1] + v[j][2] * v[j][2] + v[j][3] * v[j][3]; }
        ss = wave_sum(ss);
        const float rstd = rsqrtf(ss * (1.0f / 1024.0f) + 1e-6f);
#pragma unroll
        for (int j = 0; j < 4; ++j) {
            const f32x4 g4 = *(const f32x4*)(fg + j * 256 + lane * 4);
            *(f32x4*)(p.out + (size_t)r * DM + j * 256 + lane * 4) = v[j] * rstd * g4;
        }
    }
}

#define NPHASE 23
#ifndef DUP_S
#define DUP_S -1
#endif
#ifndef DUP_SUB
#define DUP_SUB 0
#endif
#ifdef XCC_REMAP
#define BID_SRC __builtin_amdgcn_readfirstlane(*(volatile int*)(lds + LDS_MISC + 976))
#else
#define BID_SRC blockIdx.x
#endif
#define LAUNDER() DP p; *(Params*)&p = p_in; int tid = threadIdx.x; { int bid_ = BID_SRC, nblk_ = gridDim.x; \
    asm volatile("" : "+v"(tid)); asm volatile("" : "+s"(p.ws)); asm volatile("" : "+s"(bid_)); asm volatile("" : "+s"(nblk_)); p.bid = bid_; p.nblk = nblk_; }
#define GBAR() { gchar* wsb_ = p_in.ws; asm volatile("" : "+s"(wsb_)); xcd_barrier((unsigned*)(wsb_ + OFF_BAR), st); }
#define REP(s_) _Pragma("unroll 1") for (int r_ = (DUP_S == (s_) ? 0 : 1); r_ < 2; ++r_)

#ifndef ONLY
#define ONLY -1
#endif
#ifndef FAKE
#define FAKE 0
#endif
#define ON(k) (ONLY < 0 || ONLY == (k))
#define RUN_LAYER(L) \
    if (L == 0) { if (ON(0)) { LAUNDER(); REP(0) { norm_pass(p, L, 0, tid); conv_weights(p, L, lds, tid); } } GBAR(); }     \
    if (ON(1)) { LAUNDER(); REP(1) phase_inproj(p, L, lds, tid, r_ == 0 ? FAKE : 0); } GBAR(); \
    if (ON(2)) { LAUNDER(); REP(2) phase_mla(p, L, lds, tid); } GBAR(); \
    if (ON(3)) { LAUNDER(); REP(3) phase_mixers(p, L, lds, tid, r_ == 0 ? DUP_SUB : 15); } GBAR(); \
    if (ON(4)) { LAUNDER(); REP(4) phase_combine(p, L, tid); } GBAR(); \
    if (ON(5)) { LAUNDER(); REP(5) phase_merge(p, L, lds, tid); phase_convq(p, L, lds, tid); } GBAR(); \
    if (ON(6)) { LAUNDER(); phase_wout(p, L, lds, tid); } GBAR(); \
    if (ON(7)) { LAUNDER(); REP(7) { norm_pass(p, L, 1, tid); } } GBAR(); \
    if (ON(8)) { LAUNDER(); REP(8) phase_peerq(p, L, lds, tid); if (L + 1 < DEPTH_ && CONVW_IN8) conv_weights(p, L + 1, lds, tid, 1); } GBAR();     \
    if (ON(9)) { LAUNDER(); if (DUP_S == 9) phase_peer<true>(p, L, lds, tid); phase_peer<false>(p, L, lds, tid); if (L + 1 < DEPTH_) { if (!CONVW_IN8) conv_weights(p, L + 1, lds, tid, 1); conv_weights(p, L + 1, lds, tid, 2); } } if (L != DEPTH_ - 1) GBAR();

__global__ void __launch_bounds__(NTHREADS, 2) fwd_kernel(Params p_in) {
    __shared__ __attribute__((aligned(16))) char lds[LDS_BYTES];
    volatile unsigned* st = (volatile unsigned*)(lds + LDS_MISC + 1008);
    if (threadIdx.x == 0) {
        st[0] = 0u; st[1] = 0u;
#ifdef XCC_REMAP
        const unsigned xcc = xb_xcc_id() & 7u;
        const unsigned rank = xb_add((unsigned*)(p_in.ws + OFF_BAR) + 3712 + 16 * xcc, 1u);
        *(volatile int*)(lds + LDS_MISC + 976) = (int)(rank * 8u + xcc);
#endif
    }
    __syncthreads();
    xcd_barrier_post((unsigned*)(p_in.ws + OFF_BAR));
    { LAUNDER(); phase_p0(p, lds, tid); } GBAR();
    { LAUNDER(); phase_p0b(p, tid); } GBAR();
    RUN_LAYER(0)
    RUN_LAYER(1)
}

extern "C" void kernel_launch(void* const* d_in, const int* in_sizes, int n_in, void* d_out, int out_size, void* d_ws, size_t ws_size, hipStream_t stream) {
    static int grid_blocks = 0;
    if (!grid_blocks) {
        int dev = 0, cus = 0, per_cu = 0;
        hipGetDevice(&dev);
        hipDeviceGetAttribute(&cus, hipDeviceAttributeMultiprocessorCount, dev);
        hipOccupancyMaxActiveBlocksPerMultiprocessor(&per_cu, fwd_kernel, NTHREADS, 0);
        if (per_cu > 2) per_cu = 2;
        if (per_cu < 1) per_cu = 1;
        grid_blocks = cus * per_cu;
        if (ws_size < OFF_TOP) fprintf(stderr, "workspace too small: %zu < %zu\n", ws_size, (size_t)OFF_TOP);
    }
    Params p{};
    for (int i = 0; i < 28; ++i) p.in[i] = (const float*)d_in[i];
    p.out = (float*)d_out;
    p.ws = (gchar*)d_ws;
#if MEGA
    hipMemsetAsync(d_ws, 0, 16384, stream);
    void* args[] = {&p};
    hipError_t e = hipLaunchCooperativeKernel((void*)fwd_kernel, dim3(grid_blocks), dim3(NTHREADS), args, 0, stream);
    if (e != hipSuccess) fprintf(stderr, "cooperative launch failed: %s (grid %d)\n", hipGetErrorString(e), grid_blocks);
#endif
}
```

```cpp
#include <hip/hip_runtime.h>
#include <stdint.h>
#include <stdio.h>

#ifndef MEGA
#define MEGA 1
#endif

typedef unsigned short bf16_t;
typedef short bf16x8 __attribute__((ext_vector_type(8)));
typedef float f32x4 __attribute__((ext_vector_type(4)));
typedef unsigned u32x4 __attribute__((ext_vector_type(4)));
typedef unsigned u32x2 __attribute__((ext_vector_type(2)));
typedef __bf16 bf16x2_t __attribute__((ext_vector_type(2)));

#define NB 8
#define SEQ 2048
#define CTXL 256
#define TU 2304
#define RR (NB * TU)
#define DM 1024
#define PW 3072
#define NTHREADS 256
#define LOG2E 1.4426950408889634f

#define PC_AQ 0
#define PC_AK1 512
#define PC_AK2 768
#define PC_CQ 1024
#define PC_CKV 1280
#define PC_HOH 1408
#define PC_HG 1920
#define PC_DQ 2432
#define PC_DK 2944

#define OFF_BAR   ((size_t)0)
#define OFF_MODP  ((size_t)16384)
#define OFF_MOD   (OFF_MODP + (size_t)2 * 8 * 9 * 6144 * 4)
#define OFF_ROPE  (OFF_MOD + (size_t)2 * 9 * 6144 * 4)
#define OFF_LB    (OFF_ROPE + (size_t)2048 * 32 * 8)
#define OFF_LAM   (OFF_LB + (size_t)2 * 2 * 512 * 4)
#define OFF_X     (OFF_LAM + (size_t)256)
#define OFF_HX    (OFF_X + (size_t)RR * DM * 4)
#define OFF_WIN   (OFF_HX + (size_t)RR * DM * 2)
#define OFF_WV    (OFF_WIN + (size_t)2688 * 1024 * 2)
#define OFF_WG    (OFF_WV + (size_t)2688 * 1024 * 2)
#define OFF_WUQ   (OFF_WG + (size_t)4096 * 1024 * 2)
#define OFF_WUK   (OFF_WUQ + (size_t)768 * 256 * 2)
#define OFF_WUV   (OFF_WUK + (size_t)512 * 128 * 2)
#define OFF_WBR   (OFF_WUV + (size_t)512 * 128 * 2)
#define OFF_WOUT  (OFF_WBR + (size_t)4 * 1024 * 512 * 2)
#define OFF_WPQ   (OFF_WOUT + (size_t)1024 * 1024 * 2)
#define OFF_KEYS  (OFF_WPQ + (size_t)1024 * 1024 * 2)
#define OFF_P     (OFF_KEYS + (size_t)8 * 2 * 128 * 64 * 2)
#define OFF_QB    (OFF_P + (size_t)RR * PW * 2)
#define OFF_KB    (OFF_QB + (size_t)RR * 768 * 2)
#define OFF_VTB   (OFF_KB + (size_t)RR * 768 * 2)
#define OFF_VTA   (OFF_VTB + (size_t)NB * 4 * 128 * TU * 2)
#define OFF_VTD   (OFF_VTA + (size_t)NB * 4 * 128 * TU * 2)
#define OFF_OA12  (OFF_VTD + (size_t)NB * 2 * 64 * TU * 2)
#define OFF_OB    (OFF_OA12 + (size_t)RR * 1024 * 2)
#define OFF_OHB   (OFF_OB + (size_t)RR * 512 * 2)
#define OFF_HT    (OFF_OHB + (size_t)RR * 512 * 2)
#define OFF_END   (OFF_HT + (size_t)NB * 4 * 4 * 128 * TU * 2)
#define OFF_Y     OFF_OA12
#define OFF_PQ    OFF_QB
#define OFF_TU    OFF_END
#define OFF_TV    (OFF_END + (size_t)16384 * 768)
#define OFF_SU    (OFF_END + (size_t)2 * 16384 * 768)
#define OFF_SV    (OFF_SU + 65536)
#define OFF_KEYS2 (OFF_SV + 65536)
#define KEYS_OFF(l) (((l) & 1) ? OFF_KEYS2 : OFF_KEYS)
#define OFF_TOP   (OFF_KEYS2 + (size_t)8 * 2 * 128 * 64 * 2)

typedef __attribute__((address_space(1))) char gchar;
struct Params {
    const float* in[28];
    float* out;
    gchar* ws;
};
struct DP : Params { int bid; int nblk; };

enum { I_X = 0, I_C, I_CTX, I_CCTX, I_WMOD, I_BMOD, I_N1G, I_N2G, I_WIN, I_LQ1, I_LK1, I_LQ2, I_LK2, I_DNG, I_QNG, I_KVNG, I_WUQ, I_WUKV,
       I_HLB, I_HNG, I_SINK, I_WBR, I_WOUT, I_PWQ, I_PKEYS, I_PU, I_PV, I_FG };

__device__ __forceinline__ unsigned f2bf(float f) { return (unsigned)__builtin_bit_cast(unsigned short, (__bf16)f); }
__device__ __forceinline__ float bflo(unsigned w) { return __uint_as_float(w << 16); }
__device__ __forceinline__ float bfhi(unsigned w) { return __uint_as_float(w & 0xffff0000u); }
__device__ __forceinline__ unsigned pack2(float a, float b) { bf16x2_t v = {(__bf16)a, (__bf16)b}; return __builtin_bit_cast(unsigned, v); }
__device__ __forceinline__ float wave_sum(float v) {
#pragma unroll
    for (int o = 32; o >= 1; o >>= 1) v += __shfl_xor(v, o);
    return v;
}
typedef unsigned v2u_t __attribute__((ext_vector_type(2)));
__device__ __forceinline__ float fmax_raw(float a, float b) { float r; asm("v_max_f32 %0, %1, %2" : "=v"(r) : "v"(a), "v"(b)); return r; }
__device__ __forceinline__ float rows_max(float v) {
    const v2u_t a = __builtin_amdgcn_permlane16_swap(__float_as_uint(v), __float_as_uint(v), false, false);
    v = fmax_raw(__uint_as_float(a.x), __uint_as_float(a.y));
    const v2u_t b = __builtin_amdgcn_permlane32_swap(__float_as_uint(v), __float_as_uint(v), false, false);
    return fmax_raw(__uint_as_float(b.x), __uint_as_float(b.y));
}
__device__ __forceinline__ float rows_sum(float v) {
    const v2u_t a = __builtin_amdgcn_permlane16_swap(__float_as_uint(v), __float_as_uint(v), false, false);
    v = __uint_as_float(a.x) + __uint_as_float(a.y);
    const v2u_t b = __builtin_amdgcn_permlane32_swap(__float_as_uint(v), __float_as_uint(v), false, false);
    return __uint_as_float(b.x) + __uint_as_float(b.y);
}
__device__ __forceinline__ float sigmoidf_(float x) { return 1.0f / (1.0f + __expf(-x)); }
__device__ __forceinline__ float siluf_(float x) { return x / (1.0f + __expf(-x)); }
__device__ __forceinline__ float dot2bf(unsigned a, unsigned b, float acc) {
    return __builtin_amdgcn_fdot2_f32_bf16(__builtin_bit_cast(bf16x2_t, a), __builtin_bit_cast(bf16x2_t, b), acc, false);
}

#define XB_TMO      128
#define XB_XCNT(j)  (256  + 64 * (j))
#define XB_XSUB(j)  (1280 + 64 * (j))
#define XB_XGEN(j)  (2304 + 64 * (j))
#define XB_TOP      3328
#define XB_TOPGEN   3392
#define XCD_BAR_WORDS 3456
#define XB_SPIN_CAP (1u << 22)
#define LAS __attribute__((address_space(3)))

__device__ __forceinline__ unsigned xb_ld(unsigned* p)              { return __hip_atomic_load(p, __ATOMIC_RELAXED, __HIP_MEMORY_SCOPE_AGENT); }
__device__ __forceinline__ unsigned xb_add(unsigned* p, unsigned v) { return __hip_atomic_fetch_add(p, v, __ATOMIC_RELAXED, __HIP_MEMORY_SCOPE_AGENT); }
__device__ __forceinline__ unsigned xb_xcc_id() { return (unsigned)__builtin_amdgcn_s_getreg((3 << 11) | 20) & 0xFu; }
#define XB_SPIN(cond, bar) do { unsigned _sp = 0; while (cond) { __builtin_amdgcn_s_sleep(1); \
    if ((++_sp & 255u) == 0u) { if (xb_ld(&(bar)[XB_TMO])) break; if (_sp > XB_SPIN_CAP) { atomicAdd(&(bar)[XB_TMO], 1u); break; } } } } while (0)

__device__ __forceinline__ void xcd_barrier_post(unsigned* bar) {
    if (threadIdx.x == 0) (void)xb_add(&bar[XB_XCNT(xb_xcc_id())], 1u);
}
__device__ __forceinline__ void xcd_barrier_complete(unsigned* bar, unsigned x, unsigned& nloc, unsigned& nx) {
    const unsigned G = gridDim.x;
    unsigned sum, cnt, mine, sp = 0u;
    for (;;) {
        sum = 0u; cnt = 0u; mine = 0u;
#pragma unroll 1
        for (unsigned j = 0; j < 16; ++j) { const unsigned c = xb_ld(&bar[XB_XCNT(j)]); sum += c; cnt += (c > 0u) ? 1u : 0u; mine = (j == x) ? c : mine; }
        if (sum == G) break;
        __builtin_amdgcn_s_sleep(1);
        if ((++sp & 255u) == 0u) { if (xb_ld(&bar[XB_TMO])) break; if (sp > XB_SPIN_CAP) { atomicAdd(&bar[XB_TMO], 1u); break; } }
    }
    nloc = mine > 0u ? mine : 1u; nx = cnt > 0u ? cnt : 1u;
}
__device__ __forceinline__ void xcd_barrier(unsigned* bar, volatile unsigned* st) {
    asm volatile("s_waitcnt vmcnt(0)" ::: "memory");
    __syncthreads();
    if (threadIdx.x == 0) {
        const unsigned x = xb_xcc_id();
        __builtin_amdgcn_s_waitcnt(0);
        unsigned nloc = st[0], nx = st[1];
        if (nloc == 0u) { xcd_barrier_complete(bar, x, nloc, nx); st[0] = nloc; st[1] = nx; }
        const unsigned old = xb_add(&bar[XB_XSUB(x)], 1u);
        const unsigned gen = old / nloc;
        if (old + 1u == (gen + 1u) * nloc) {
            __builtin_amdgcn_fence(__ATOMIC_RELEASE, "agent");
            asm volatile("s_waitcnt vmcnt(0)" ::: "memory");
            const unsigned og = xb_add(&bar[XB_TOP], 1u);
            const unsigned tg = og / nx;
            if (og + 1u == (tg + 1u) * nx) xb_add(&bar[XB_TOPGEN], 1u);
            else XB_SPIN(xb_ld(&bar[XB_TOPGEN]) == tg, bar);
            __builtin_amdgcn_fence(__ATOMIC_ACQUIRE, "agent");
            xb_add(&bar[XB_XGEN(x)], 1u);
            asm volatile("s_waitcnt vmcnt(0)" ::: "memory");
        } else {
            XB_SPIN(xb_ld(&bar[XB_XGEN(x)]) == gen, bar);
            __builtin_amdgcn_fence(__ATOMIC_ACQUIRE, "agent");
            asm volatile("s_waitcnt vmcnt(0)" ::: "memory");
        }
    }
    __syncthreads();
}

#define LDS_BYTES 74752
#define LDS_MISC  73728

__device__ __forceinline__ void phase_p0(const DP& p, char* lds, int tid) {
    float* modp = (float*)(p.ws + OFF_MODP);
    float* sl = (float*)lds;
    const int nitems = 2 * 8 * 24;
    for (int it = p.bid; it < nitems; it += p.nblk) {
        const int l = it / 192, rem = it % 192, ks = rem / 24, cb = rem % 24;
        const int k0 = ks * 128;
        __syncthreads();
        for (int e = tid; e < 9 * 128; e += NTHREADS) {
            const int r = e >> 7, k = e & 127;
            const float cv = (r < 8) ? p.in[I_C][r * DM + k0 + k] : p.in[I_CCTX][k0 + k];
            sl[e] = siluf_(cv);
        }
        __syncthreads();
        const int col = cb * 256 + tid;
        const float* w = p.in[I_WMOD] + (size_t)l * DM * 6144 + (size_t)k0 * 6144 + col;
        float acc[9];
#pragma unroll
        for (int r = 0; r < 9; ++r) acc[r] = 0.f;
        for (int k = 0; k < 128; ++k) {
            const float wv = w[(size_t)k * 6144];
#pragma unroll
            for (int r = 0; r < 9; ++r) acc[r] += sl[r * 128 + k] * wv;
        }
#pragma unroll
        for (int r = 0; r < 9; ++r) modp[((size_t)(l * 8 + ks) * 9 + r) * 6144 + col] = acc[r];
    }
    float2* rope = (float2*)(p.ws + OFF_ROPE);
    for (int e = p.bid * NTHREADS + tid; e < 2048 * 32; e += p.nblk * NTHREADS) {
        const int t = e >> 5, a = (e >> 4) & 1, i = e & 15;
        const float freq = exp2f(-(float)i * (13.287712379549449f / 16.0f));
        const float pos = (float)(a == 0 ? (t >> 6) : (t & 63));
        const float ang = pos * freq;
        rope[e] = make_float2(cosf(ang), sinf(ang));
    }
    float* lb = (float*)(p.ws + OFF_LB);
    for (int e = p.bid * NTHREADS + tid; e < 2 * 512; e += p.nblk * NTHREADS) {
        const int d = e >> 9, c = e & 511;
        const float h0 = p.in[I_HLB][(d * 2 + 0) * 512 + c], h1 = p.in[I_HLB][(d * 2 + 1) * 512 + c];
        const float mx = fmaxf(h0, h1);
        const float e0 = expf(h0 - mx), e1 = expf(h1 - mx);
        const float p1 = e1 / (e0 + e1);
        lb[(d * 2 + 0) * 512 + c] = 0.f;
        lb[(d * 2 + 1) * 512 + c] = p1;
    }
    if (p.bid == 0 && tid < 2) {
        const int l = tid;
        float s1 = 0.f, s2 = 0.f;
        for (int i = 0; i < 64; ++i) {
            s1 += p.in[I_LQ1][l * 64 + i] * p.in[I_LK1][l * 64 + i];
            s2 += p.in[I_LQ2][l * 64 + i] * p.in[I_LK2][l * 64 + i];
        }
        const float lam_init = 0.8f - 0.6f * expf(-0.3f * (float)l);
        float* lam = (float*)(p.ws + OFF_LAM);
        lam[l * 2 + 0] = expf(s1) - expf(s2) + lam_init;
        lam[l * 2 + 1] = lam_init;
    }
}

__device__ __forceinline__ void phase_p0b(const DP& p, int tid) {
    const float* modp = (const float*)(p.ws + OFF_MODP);
    float* mod = (float*)(p.ws + OFF_MOD);
    for (int e = p.bid * NTHREADS + tid; e < 2 * 9 * 6144; e += p.nblk * NTHREADS) {
        const int l = e / (9 * 6144), rem = e % (9 * 6144), r = rem / 6144, col = rem % 6144;
        float s = p.in[I_BMOD][l * 6144 + col];
#pragma unroll
        for (int ks = 0; ks < 8; ++ks) s += modp[((size_t)(l * 8 + ks) * 9 + r) * 6144 + col];
        mod[e] = s;
    }
}

__device__ __forceinline__ void norm_pass(const DP& p, int l, int which, int tid) {
    const int lane = tid & 63;
    const int gw = p.bid * 4 + (tid >> 6), nw = p.nblk * 4;
    const float* gvec = p.in[which ? I_N2G : I_N1G] + l * DM;
    const float* mod = (const float*)(p.ws + OFF_MOD) + (size_t)l * 9 * 6144;
    float* X = (float*)(p.ws + OFF_X);
    bf16_t* HX = (bf16_t*)(p.ws + OFF_HX);
    const int seg_sh = which ? 3 : 0, seg_sc = which ? 4 : 1;
    for (int row = gw; row < RR; row += nw) {
        const int b = row / TU, t = row - b * TU;
        const bool isctx = t >= SEQ;
        if (which == 1 && l == 1 && isctx) continue;
        const float* src;
        if (which == 0 && l == 0) src = isctx ? p.in[I_CTX] + (size_t)(b * CTXL + t - SEQ) * DM : p.in[I_X] + (size_t)(b * SEQ + t) * DM;
        else src = X + (size_t)row * DM;
        const float* mrow = mod + (isctx ? 8 : b) * 6144;
        f32x4 v[4]; float ss = 0.f;
#pragma unroll
        for (int j = 0; j < 4; ++j) {
            v[j] = *(const f32x4*)(src + j * 256 + lane * 4);
            ss += v[j][0] * v[j][0] + v[j][1] * v[j][1] + v[j][2] * v[j][2] + v[j][3] * v[j][3];
        }
        ss = wave_sum(ss);
        const float rstd = rsqrtf(ss * (1.0f / 1024.0f) + 1e-6f);
#pragma unroll
        for (int j = 0; j < 4; ++j) {
            const int col = j * 256 + lane * 4;
            if (which == 0 && l == 0) *(f32x4*)(X + (size_t)row * DM + col) = v[j];
            const f32x4 g4 = *(const f32x4*)(gvec + col);
            const f32x4 sh = *(const f32x4*)(mrow + seg_sh * 1024 + col);
            const f32x4 sc = *(const f32x4*)(mrow + seg_sc * 1024 + col);
            float y[4];
#pragma unroll
            for (int i = 0; i < 4; ++i) y[i] = v[j][i] * rstd * g4[i] * (1.0f + sc[i]) + sh[i];
            u32x2 w; w.x = pack2(y[0], y[1]); w.y = pack2(y[2], y[3]);
            *(u32x2*)(HX + (size_t)row * DM + col) = w;
        }
    }
}

__device__ __forceinline__ void conv_tr64(const float* src, int ld, int srccol, int k0, int K, bf16_t* dst, const float* fold, float* lt, int tid, bool perm = false) {
    __syncthreads();
#pragma unroll
    for (int i = 0; i < 4; ++i) {
        const int r = (tid >> 4) + 16 * i, c4 = tid & 15;
        f32x4 val = {0.f, 0.f, 0.f, 0.f};
        if (srccol >= 0) val = *(const f32x4*)(src + (size_t)(k0 + r) * ld + srccol + c4 * 4);
        if (fold) { const float f = fold[k0 + r]; val = val * f; }
        lt[r * 65 + c4 * 4 + 0] = val[0]; lt[r * 65 + c4 * 4 + 1] = val[1]; lt[r * 65 + c4 * 4 + 2] = val[2]; lt[r * 65 + c4 * 4 + 3] = val[3];
    }
    __syncthreads();
    const int n = tid >> 2, seg = tid & 3;
    unsigned w[8];
#pragma unroll
    for (int i = 0; i < 8; ++i) w[i] = pack2(lt[(seg * 16 + 2 * i) * 65 + n], lt[(seg * 16 + 2 * i + 1) * 65 + n]);
    const int nrow = perm ? (((n >> 4) & 1) * 32 + ((n >> 2) & 1) * 16 + (n >> 5) * 8 + ((n >> 3) & 1) * 4 + (n & 3)) : n;
    bf16_t* d = dst + (size_t)nrow * K + k0 + seg * 16;
    u32x4 a = {w[0], w[1], w[2], w[3]}, bq = {w[4], w[5], w[6], w[7]};
    *(u32x4*)d = a; *(u32x4*)(d + 8) = bq;
}

__device__ __forceinline__ int win_srccol(int chunk) {
    if (chunk < 8) return (chunk & 1) * 256 + (chunk >> 1) * 64;
    if (chunk < 16) return 512 + (chunk - 8) * 64;
    if (chunk < 22) return 1536 + (chunk - 16) * 64;
    if (chunk < 30) return 4032 + (chunk - 22) * 64;
    if (chunk < 40) return 4544 + (chunk - 30) * 64;
    if (chunk == 40) return 1920;
    return -1;
}
__device__ __forceinline__ int wt_srccol(int chunk) {
    if (chunk < 8) return 1024 + chunk * 64;
    if (chunk < 10) return 5184 + (chunk - 8) * 64;
    return 1984 + (chunk - 10) * 64;
}

__device__ __forceinline__ void conv_weights(const DP& p, int l, char* lds, int tid, int part = 0) {
    float* lt = (float*)lds;
    const float* w_in = p.in[I_WIN] + (size_t)l * DM * 9408;
    const int n_main = 42 * 16, n_v = 42 * 16, n_g = 64 * 16, n_uq = 12 * 4, n_uk = 8 * 2, n_uv = 8 * 2, n_br = 4 * 16 * 8, n_out = 256, n_pq = 256, n_keys = 64;
    const int total = n_main + n_v + n_g + n_uq + n_uk + n_uv + n_br + n_out + n_pq + n_keys;
    const int lo = part == 2 ? total - n_pq - n_keys : 0, hi = part == 1 ? total - n_pq - n_keys : total;
    unsigned* qctr = (unsigned*)(p.ws + OFF_BAR) + 3520 + 64 * (l & 1) + 48;
    volatile int* slot = (volatile int*)(lds + 73728 + 992);
    asm volatile("s_waitcnt vmcnt(0)" ::: "memory");
    __syncthreads();
    for (int it0 = lo + p.bid; ; it0 += p.nblk) {
        if (part == 1) {
            __syncthreads();
            if (tid == 0) *slot = (int)atomicAdd(qctr, 1u);
            __syncthreads();
            it0 = lo + *slot;
        }
        if (it0 >= hi) break;
        int it = it0;
        if (it < n_main) { const int ch = it >> 4, kb = it & 15;
            conv_tr64(w_in, 9408, win_srccol(ch), kb * 64, 1024, (bf16_t*)(p.ws + OFF_WIN) + (size_t)ch * 64 * 1024, nullptr, lt, tid, true); continue; }
        it -= n_main;
        if (it < n_v) { const int ch = it >> 4, kb = it & 15;
            conv_tr64(w_in, 9408, wt_srccol(ch), kb * 64, 1024, (bf16_t*)(p.ws + OFF_WV) + (size_t)ch * 64 * 1024, nullptr, lt, tid); continue; }
        it -= n_v;
        if (it < n_g) { const int ch = it >> 4, kb = it & 15;
            conv_tr64(w_in, 9408, 5312 + ch * 64, kb * 64, 1024, (bf16_t*)(p.ws + OFF_WG) + (size_t)ch * 64 * 1024, nullptr, lt, tid); continue; }
        it -= n_g;
        if (it < n_uq) { const int ch = it >> 2, kb = it & 3;
            conv_tr64(p.in[I_WUQ] + (size_t)l * 256 * 768, 768, ch * 64, kb * 64, 256, (bf16_t*)(p.ws + OFF_WUQ) + (size_t)ch * 64 * 256, p.in[I_QNG] + l * 256, lt, tid); continue; }
        it -= n_uq;
        if (it < n_uk) { const int ch = it >> 1, kb = it & 1;
            conv_tr64(p.in[I_WUKV] + (size_t)l * 128 * 1024, 1024, (ch >> 1) * 256 + (ch & 1) * 64, kb * 64, 128, (bf16_t*)(p.ws + OFF_WUK) + (size_t)ch * 64 * 128, p.in[I_KVNG] + l * 128, lt, tid); continue; }
        it -= n_uk;
        if (it < n_uv) { const int ch = it >> 1, kb = it & 1;
            conv_tr64(p.in[I_WUKV] + (size_t)l * 128 * 1024, 1024, (ch >> 1) * 256 + 128 + (ch & 1) * 64, kb * 64, 128, (bf16_t*)(p.ws + OFF_WUV) + (size_t)ch * 64 * 128, p.in[I_KVNG] + l * 128, lt, tid); continue; }
        it -= n_uv;
        if (it < n_br) { const int j = it >> 7, r2 = it & 127, ch = r2 >> 3, kb = r2 & 7;
            conv_tr64(p.in[I_WBR] + ((size_t)l * 4 + j) * 512 * 1024, 1024, ch * 64, kb * 64, 512, (bf16_t*)(p.ws + OFF_WBR) + (size_t)j * 1024 * 512 + (size_t)ch * 64 * 512, nullptr, lt, tid); continue; }
        it -= n_br;
        if (it < n_out) { const int ch = it >> 4, kb = it & 15;
            conv_tr64(p.in[I_WOUT] + (size_t)l * 1024 * 1024, 1024, ch * 64, kb * 64, 1024, (bf16_t*)(p.ws + OFF_WOUT) + (size_t)ch * 64 * 1024, nullptr, lt, tid); continue; }
        it -= n_out;
        if (it < n_pq) { const int ch = it >> 4, kb = it & 15;
            conv_tr64(p.in[I_PWQ] + (size_t)l * 1024 * 1024, 1024, ch * 64, kb * 64, 1024, (bf16_t*)(p.ws + OFF_WPQ) + (size_t)ch * 64 * 1024, nullptr, lt, tid); continue; }
        it -= n_pq;
        {
            const float* ks = p.in[I_PKEYS] + (size_t)l * 131072 + (size_t)it * 2048 + tid * 8;
            const f32x4 a = *(const f32x4*)ks, bq = *(const f32x4*)(ks + 4);
            u32x4 w = {pack2(a[0], a[1]), pack2(a[2], a[3]), pack2(bq[0], bq[1]), pack2(bq[2], bq[3])};
            *(u32x4*)((bf16_t*)(p.ws + KEYS_OFF(l)) + (size_t)it * 2048 + tid * 8) = w;
        }
    }
    __syncthreads();
}

#ifndef EB
#define EB 2
#endif
#define TROW 768
#ifndef FAKEIDX
#define FAKEIDX 0
#endif
#define DEPTH_ 2
#ifndef FOLD_ALL
#define FOLD_ALL 1
#endif
#ifndef CONVW_IN8
#define CONVW_IN8 0
#endif
#ifndef NODEC
#define NODEC 0
#endif
#ifndef SKIP
#define SKIP 0
#endif
__device__ __forceinline__ unsigned enc_e2m3(float x, float inv) {
    const float a = fabsf(x) * inv;
    float cf;
    if (a < 2.0f) cf = rintf(a * 8.0f); else if (a < 4.0f) cf = 16.0f + rintf((a - 2.0f) * 4.0f); else cf = 24.0f + rintf((a - 4.0f) * 2.0f);
    unsigned code = (unsigned)fminf(cf, 31.0f);
    return code | ((__float_as_uint(x) >> 31) << 5);
}
#define NCONV 512
__device__ __forceinline__ void conv_tables_item(const DP& p, int l, int item, int tid) {
    const int lane = tid & 63;
    const int j = lane >> 4, c = lane & 15;
    {
        const int tb = item >> 8;
        const int rbase = (item & 255) * 64 + (tid >> 6) * 16;
        const float* src = p.in[tb ? I_PV : I_PU] + (size_t)l * 16384 * 1024;
        unsigned char* dst = (unsigned char*)(p.ws + (tb ? OFF_TV : OFF_TU));
        float* scl = (float*)(p.ws + (tb ? OFF_SV : OFF_SU));
#pragma unroll 1
        for (int r0 = rbase; r0 < rbase + 16; r0 += 2) {
            f32x4 a[2][4];
#pragma unroll
            for (int rr = 0; rr < 2; ++rr)
#pragma unroll
                for (int q = 0; q < 4; ++q) a[rr][q] = *(const f32x4*)(src + (size_t)(r0 + rr) * 1024 + lane * 16 + q * 4);
#pragma unroll
            for (int rr = 0; rr < 2; ++rr) {
                float mx = 0.f;
#pragma unroll
                for (int q = 0; q < 4; ++q)
#pragma unroll
                    for (int i = 0; i < 4; ++i) mx = fmaxf(mx, fabsf(a[rr][q][i]));
#pragma unroll
                for (int o = 32; o >= 1; o >>= 1) mx = fmaxf(mx, __shfl_xor(mx, o));
                mx = fmaxf(mx, 1e-30f);
                const float inv = 7.5f / mx;
                unsigned d0 = 0u, d1 = 0u, d2 = 0u;
#pragma unroll
                for (int t = 0; t < 16; ++t) {
                    const unsigned code = enc_e2m3(a[rr][t >> 2][t & 3], inv);
                    const int bit = 6 * t, w = bit >> 5, sh = bit & 31;
                    if (w == 0) d0 |= code << sh; else if (w == 1) d1 |= code << sh; else d2 |= code << sh;
                    if (sh > 26) { if (w == 0) d1 |= code >> (32 - sh); else d2 |= code >> (32 - sh); }
                }
                unsigned char* o = dst + (size_t)(r0 + rr) * TROW + c * 16;
                const int n0 = 3 * j;
                *(unsigned*)(o + (n0 >> 2) * 256 + (n0 & 3) * 4) = d0;
                *(unsigned*)(o + ((n0 + 1) >> 2) * 256 + ((n0 + 1) & 3) * 4) = d1;
                *(unsigned*)(o + ((n0 + 2) >> 2) * 256 + ((n0 + 2) & 3) * 4) = d2;
                if (lane == 0) scl[r0 + rr] = mx * (1.0f / 7.5f);
            }
        }
    }
}

template <int BN, bool SWAP>
__device__ __forceinline__ void gemm_core(const bf16_t* __restrict__ A, int lda, const bf16_t* __restrict__ Bt, int ldb, int K,
                                          f32x4 (&acc)[4][BN / 32], char* lds, int tid,
                                          int& par, bool pre = false, const bf16_t* An = nullptr, int ldan = 0, const bf16_t* Bn = nullptr, int ldbn = 0) {
    constexpr int NF = BN / 32, NBL = BN / 32;
    const int lane = tid & 63, wid = tid >> 6, wr = wid >> 1, wc = wid & 1, g = lane >> 4, c = lane & 15;
    char* As = lds;
    char* Bs = lds + 32768;
    const int nk = K >> 6;
    const int srow = wid * 8 + (lane >> 3), scc = (lane & 7) ^ (lane >> 3);
    auto stage = [&](const bf16_t* Ab, int lda_, const bf16_t* Bb, int ldb_, int kt, int buf) {
        const bf16_t* a_src = Ab + (size_t)srow * lda_ + scc * 8;
        const bf16_t* b_src = Bb + (size_t)srow * ldb_ + scc * 8;
#pragma unroll
        for (int i = 0; i < 4; ++i)
            __builtin_amdgcn_global_load_lds((const unsigned*)(a_src + (size_t)i * 32 * lda_ + kt * 64), (LAS unsigned*)(As + buf * 16384 + (i * 4 + wid) * 1024), 16, 0, 0);
#pragma unroll
        for (int i = 0; i < NBL; ++i)
            __builtin_amdgcn_global_load_lds((const unsigned*)(b_src + (size_t)i * 32 * ldb_ + kt * 64), (LAS unsigned*)(Bs + buf * (BN * 128) + (i * 4 + wid) * 1024), 16, 0, 0);
    };
    const char* a_rd[2]; const char* b_rd[2];
#pragma unroll
    for (int kk = 0; kk < 2; ++kk) {
        a_rd[kk] = As + (wr * 64 + c) * 128 + (((kk * 4 + g) ^ (c & 7)) << 4);
        b_rd[kk] = Bs + (wc * (BN / 2) + c) * 128 + (((kk * 4 + g) ^ (c & 7)) << 4);
    }
    if (!pre) {
        __syncthreads();
        stage(A, lda, Bt, ldb, 0, par);
        asm volatile("s_waitcnt vmcnt(0)" ::: "memory");
        __syncthreads();
    }
    for (int kt = 0; kt < nk; ++kt) {
        const int buf = (par + kt) & 1;
        if (kt + 1 < nk) stage(A, lda, Bt, ldb, kt + 1, buf ^ 1);
        else if (An) stage(An, ldan, Bn, ldbn, 0, buf ^ 1);
#pragma unroll
        for (int kk = 0; kk < 2; ++kk) {
            bf16x8 af[4], bfr[NF];
#pragma unroll
            for (int m = 0; m < 4; ++m) af[m] = *(const bf16x8*)(a_rd[kk] + buf * 16384 + m * 2048);
#pragma unroll
            for (int n = 0; n < NF; ++n) bfr[n] = *(const bf16x8*)(b_rd[kk] + buf * (BN * 128) + n * 2048);
#pragma unroll
            for (int m = 0; m < 4; ++m)
#pragma unroll
                for (int n = 0; n < NF; ++n)
                    acc[m][n] = SWAP ? __builtin_amdgcn_mfma_f32_16x16x32_bf16(bfr[n], af[m], acc[m][n], 0, 0, 0)
                                     : __builtin_amdgcn_mfma_f32_16x16x32_bf16(af[m], bfr[n], acc[m][n], 0, 0, 0);
        }
        asm volatile("s_waitcnt vmcnt(0)" ::: "memory");
        __syncthreads();
    }
    par = (par + nk) & 1;
}

template <bool SWAP>
__device__ __forceinline__ void gemm256(const bf16_t* __restrict__ A, int lda, const bf16_t* __restrict__ Bt, int ldb, int K,
                                        f32x4 (&acc)[8][4], char* lds, int tid) {
    const int lane = tid & 63, wid = tid >> 6, wr = wid >> 1, wc = wid & 1, g = lane >> 4, c = lane & 15;
    const int nk = K >> 5;
    const int srow = wid * 16 + (lane >> 2), scc = ((lane & 3) + 2 * ((lane >> 4) & 3)) & 3;
    const bf16_t* a_src = A + (size_t)srow * lda + scc * 8;
    const bf16_t* b_src = Bt + (size_t)srow * ldb + scc * 8;
    auto stage = [&](int kt, int boff) {
#pragma unroll
        for (int i = 0; i < 4; ++i)
            __builtin_amdgcn_global_load_lds((const unsigned*)(a_src + (size_t)i * 64 * lda + kt * 32), (LAS unsigned*)(lds + boff + (i * 4 + wid) * 1024), 16, 0, 0);
#pragma unroll
        for (int i = 0; i < 2; ++i)
            __builtin_amdgcn_global_load_lds((const unsigned*)(b_src + (size_t)i * 64 * ldb + kt * 32), (LAS unsigned*)(lds + boff + 16384 + (i * 4 + wid) * 1024), 16, 0, 0);
    };
    const int slot = ((g + 2 * (c >> 2)) & 3) << 4;
    const char* a_rd = lds + (wr * 128 + c) * 64 + slot;
    const char* b_rd = lds + 16384 + (wc * 64 + c) * 64 + slot;
    __syncthreads();
    stage(0, 0);
    stage(1, 24576);
    int cur = 0, nxt2 = 49152;
    for (int kt = 0; kt < nk; ++kt) {
        if (kt + 1 < nk) asm volatile("s_waitcnt vmcnt(6)" ::: "memory"); else asm volatile("s_waitcnt vmcnt(0)" ::: "memory");
        __builtin_amdgcn_s_barrier();
        asm volatile("" ::: "memory");
        if (kt + 2 < nk) stage(kt + 2, nxt2);
        bf16x8 af[8], bfr[4];
#pragma unroll
        for (int m = 0; m < 8; ++m) af[m] = *(const bf16x8*)(a_rd + cur + m * 1024);
#pragma unroll
        for (int n = 0; n < 4; ++n) bfr[n] = *(const bf16x8*)(b_rd + cur + n * 1024);
#pragma unroll
        for (int m = 0; m < 8; ++m)
#pragma unroll
            for (int n = 0; n < 4; ++n)
                acc[m][n] = SWAP ? __builtin_amdgcn_mfma_f32_16x16x32_bf16(bfr[n], af[m], acc[m][n], 0, 0, 0)
                                 : __builtin_amdgcn_mfma_f32_16x16x32_bf16(af[m], bfr[n], acc[m][n], 0, 0, 0);
        nxt2 = cur; cur = (cur == 49152) ? 0 : cur + 24576;
    }
    asm volatile("s_waitcnt lgkmcnt(0)" ::: "memory");
}

template <int MF, int NF>
__device__ __forceinline__ void zero_acc(f32x4 (&acc)[MF][NF]) {
#pragma unroll
    for (int m = 0; m < MF; ++m)
#pragma unroll
        for (int n = 0; n < NF; ++n) acc[m][n] = (f32x4){0.f, 0.f, 0.f, 0.f};
}

#ifndef BKT
#define BKT 64
#endif
#define QSCALE64 (0.125f * LOG2E)
#define QSCALE192 (0.07216878364870322f * LOG2E)

struct TileIter {
    int x, lb, nlb, NT, RS, per, total, lt, NM; bool xcd;
    __device__ __forceinline__ void init(const DP& p, int NT_, int RS_, int NM_ = 144) {
        NT = NT_; RS = RS_; NM = NM_; xcd = (p.nblk & 7) == 0 && p.nblk >= 8;
        if (xcd) { x = p.bid & 7; lb = p.bid >> 3; nlb = p.nblk >> 3; per = RS * NT; total = (NM / 8) * NT; }
        else { x = 0; lb = p.bid; nlb = p.nblk; per = 1; total = NM * NT; }
        lt = lb;
    }
    __device__ __forceinline__ bool next(int& tm, int& tn) {
        if (lt >= total) return false;
        if (xcd) { const int rg = lt / per, rem = lt - rg * per; tn = rem / RS; const int r = rem - tn * RS; tm = (rg * RS + r) * 8 + x; }
        else { tn = lt / NM; tm = lt - tn * NM; }
        lt += nlb;
        return true;
    }
};

__device__ __forceinline__ void phase_inproj(const DP& p, int l, char* lds, int tid, int fake = 0) {
    const int lane = tid & 63, wid = tid >> 6, wr = wid >> 1, wc = wid & 1, g = lane >> 4, c = lane & 15;
    const bf16_t* HX = (const bf16_t*)(p.ws + OFF_HX);
    bf16_t* P = (bf16_t*)(p.ws + OFF_P);
    bf16_t* KB = (bf16_t*)(p.ws + OFF_KB);
    const float* lb = (const float*)(p.ws + OFF_LB);
    float rfreq[2][4];
#pragma unroll
    for (int H = 0; H < 2; ++H)
#pragma unroll
        for (int r = 0; r < 4; ++r) rfreq[H][r] = exp2f(-(float)(8 * (g & 1) + 4 * H + r) * (13.287712379549449f / 16.0f)) * 0.15915494309189535f;
    TileIter ti; ti.init(p, 42, 9, 72);
    int tm, tn_all;
    while (ti.next(tm, tn_all)) {
        if (tn_all < 21) {
            const int tn = tn_all;
            const int row0 = tm * 256, col0 = tn * 128;
            f32x4 acc[8][4]; zero_acc<8, 4>(acc);
            if (fake) {
                const int fr = (fake == 1) ? 0 : row0, fc = (fake == 1) ? 0 : col0;
                gemm256<true>(HX + (size_t)fr * DM, DM, (const bf16_t*)(p.ws + OFF_WIN) + (size_t)fc * DM, DM, DM, acc, lds, tid);
#pragma unroll
                for (int m = 0; m < 8; ++m)
#pragma unroll
                    for (int n = 0; n < 4; ++n) asm volatile("" :: "v"(acc[m][n]));
                continue;
            }
            gemm256<true>(HX + (size_t)row0 * DM, DM, (const bf16_t*)(p.ws + OFF_WIN) + (size_t)col0 * DM, DM, DM, acc, lds, tid);
            __syncthreads();
            const int chunk = (col0 >> 6) + wc;
            if (chunk >= 41) continue;
            const bool is_rope = (chunk < 16) || (chunk >= 30);
            const bool is_q = (chunk < 8) || (chunk >= 30 && chunk < 38);
            const int pcol = chunk * 64 + (chunk >= 22 ? 512 : 0);
            const int fA = g >> 1, fB = g & 1;
#pragma unroll
            for (int m = 0; m < 8; ++m) {
                const int row = row0 + wr * 128 + m * 16 + c;
                const int b = row / TU, t = row - b * TU;
                f32x4 v[4];
#pragma unroll
                for (int n = 0; n < 4; ++n) v[n] = acc[m][n];
                if (is_rope && t < SEQ) {
                    const float pos = (float)(fA == 0 ? (t >> 6) : (t & 63));
#pragma unroll
                    for (int H = 0; H < 2; ++H)
#pragma unroll
                        for (int r = 0; r < 4; ++r) {
                            const float a0 = pos * rfreq[H][r];
                            const float cs = __builtin_amdgcn_cosf(a0), sn = __builtin_amdgcn_sinf(a0);
                            const float x1 = v[H][r], x2 = v[2 + H][r];
                            v[H][r] = x1 * cs - x2 * sn; v[2 + H][r] = x1 * sn + x2 * cs;
                        }
                }
                if (is_q) {
#pragma unroll
                    for (int n = 0; n < 4; ++n) v[n] = v[n] * QSCALE64;
                }
#pragma unroll
                for (int P2 = 0; P2 < 2; ++P2) {
                    u32x4 w; w.x = pack2(v[2 * P2][0], v[2 * P2][1]); w.y = pack2(v[2 * P2][2], v[2 * P2][3]);
                    w.z = pack2(v[2 * P2 + 1][0], v[2 * P2 + 1][1]); w.w = pack2(v[2 * P2 + 1][2], v[2 * P2 + 1][3]);
                    const int fo = 32 * fA + 16 * P2 + 8 * fB;
                    if (chunk < 40) *(u32x4*)(P + (size_t)row * PW + pcol + fo) = w;
                    else {
#pragma unroll
                        for (int h = 0; h < 4; ++h) *(u32x4*)(KB + (size_t)row * 768 + h * 192 + 128 + fo) = w;
                    }
                }
            }
        } else {
            const int tn = tn_all - 21;
            const int row0 = tm * 256, col0 = tn * 128;
            f32x4 acc[8][4]; zero_acc<8, 4>(acc);
            if (fake) {
                const int fr = (fake == 1) ? 0 : row0, fc = (fake == 1) ? 0 : col0;
                gemm256<false>(HX + (size_t)fr * DM, DM, (const bf16_t*)(p.ws + OFF_WV) + (size_t)fc * DM, DM, DM, acc, lds, tid);
#pragma unroll
                for (int m = 0; m < 8; ++m)
#pragma unroll
                    for (int n = 0; n < 4; ++n) asm volatile("" :: "v"(acc[m][n]));
                continue;
            }
            gemm256<false>(HX + (size_t)row0 * DM, DM, (const bf16_t*)(p.ws + OFF_WV) + (size_t)col0 * DM, DM, DM, acc, lds, tid);
            const int chunk = (col0 >> 6) + wc;
#pragma unroll
            for (int m = 0; m < 8; ++m) {
                const int rowb = row0 + wr * 128 + m * 16 + 4 * g;
                const int b = rowb / TU, t = rowb - b * TU;
#pragma unroll
                for (int n = 0; n < 4; ++n) {
                    f32x4 v = acc[m][n];
                    bf16_t* dst;
                    if (chunk < 8) dst = (bf16_t*)(p.ws + OFF_VTA) + ((size_t)((b * 4 + (chunk >> 1)) * 128 + (chunk & 1) * 64 + n * 16 + c)) * TU + t;
                    else if (chunk < 10) dst = (bf16_t*)(p.ws + OFF_VTD) + ((size_t)((b * 2 + (chunk - 8)) * 64 + n * 16 + c)) * TU + t;
                    else {
                        const int ci = chunk - 10, arr = ci >> 3, col = (ci & 7) * 64 + n * 16 + c;
                        if (arr == 1 || arr == 2) {
                            const float lbv = lb[((arr - 1) * 2 + l) * 512 + col];
#pragma unroll
                            for (int r = 0; r < 4; ++r) v[r] = (1.0f - lbv) / (1.0f + __expf(v[r]));
                        }
                        dst = (bf16_t*)(p.ws + OFF_HT) + ((size_t)(((b * 4 + (col >> 7)) * 4 + arr) * 128 + (col & 127))) * TU + t;
                    }
                    u32x2 w; w.x = pack2(v[0], v[1]); w.y = pack2(v[2], v[3]);
                    *(u32x2*)dst = w;
                }
            }
        }
    }
}

__device__ __forceinline__ void row_rstd(const bf16_t* A, int lda, int K, float* rs, int tid) {
    __syncthreads();
    const int r = tid >> 1, half = tid & 1;
    const int n = K >> 1;
    const bf16_t* ap = A + (size_t)r * lda + half * n;
    float ss = 0.f;
    for (int i = 0; i < n; i += 8) {
        const u32x4 w = *(const u32x4*)(ap + i);
#pragma unroll
        for (int j = 0; j < 4; ++j) { const float a = bflo(w[j]), bq = bfhi(w[j]); ss += a * a + bq * bq; }
    }
    ss += __shfl_xor(ss, 1);
    if (half == 0) rs[r] = rsqrtf(ss / (float)K + 1e-6f);
    __syncthreads();
}

__device__ __forceinline__ void phase_mla(const DP& p, int l, char* lds, int tid) {
    const int lane = tid & 63, wid = tid >> 6, wr = wid >> 1, wc = wid & 1, g = lane >> 4, c = lane & 15;
    const bf16_t* P = (const bf16_t*)(p.ws + OFF_P);
    bf16_t* QB = (bf16_t*)(p.ws + OFF_QB);
    bf16_t* KB = (bf16_t*)(p.ws + OFF_KB);
    float rfreq[4];
#pragma unroll
    for (int r = 0; r < 4; ++r) rfreq[r] = exp2f(-(float)(4 * g + r) * (13.287712379549449f / 16.0f)) * 0.15915494309189535f;
    float* rs = (float*)(lds + LDS_MISC);
    TileIter ti; ti.init(p, 14, 18);
    int tm, tn_all;
    while (ti.next(tm, tn_all)) {
        if (tn_all < 6) {
            const int tn = tn_all, row0 = tm * 128, col0 = tn * 128;
            const bf16_t* A = P + (size_t)row0 * PW + PC_CQ;
            row_rstd(A, PW, 256, rs, tid);
            f32x4 acc[4][4]; zero_acc<4, 4>(acc);
            { int par0 = 0; gemm_core<128, true>(A, PW, (const bf16_t*)(p.ws + OFF_WUQ) + (size_t)col0 * 256, 256, 256, acc, lds, tid, par0); }
            const int chunk = (col0 >> 6) + wc;
            const bool is_rope = (chunk % 3) == 2;
#pragma unroll
            for (int m = 0; m < 4; ++m) {
                const int rl = wr * 64 + m * 16 + c, row = row0 + rl;
                const int b = row / TU, t = row - b * TU;
                const float sc = rs[rl] * QSCALE192;
                f32x4 v[4];
#pragma unroll
                for (int n = 0; n < 4; ++n) v[n] = acc[m][n] * sc;
                if (is_rope && t < SEQ) {
#pragma unroll
                    for (int r = 0; r < 4; ++r) {
                        const float fr = rfreq[r];
                        const float a0 = (float)(t >> 6) * fr, a1 = (float)(t & 63) * fr;
                        const float2 cs0 = make_float2(__builtin_amdgcn_cosf(a0), __builtin_amdgcn_sinf(a0)), cs1 = make_float2(__builtin_amdgcn_cosf(a1), __builtin_amdgcn_sinf(a1));
                        const float x1 = v[0][r], x2 = v[1][r], y1 = v[2][r], y2 = v[3][r];
                        v[0][r] = x1 * cs0.x - x2 * cs0.y; v[1][r] = x1 * cs0.y + x2 * cs0.x;
                        v[2][r] = y1 * cs1.x - y2 * cs1.y; v[3][r] = y1 * cs1.y + y2 * cs1.x;
                    }
                }
#pragma unroll
                for (int n = 0; n < 4; ++n) {
                    u32x2 w; w.x = pack2(v[n][0], v[n][1]); w.y = pack2(v[n][2], v[n][3]);
                    *(u32x2*)(QB + (size_t)row * 768 + chunk * 64 + n * 16 + 4 * g) = w;
                }
            }
        } else if (tn_all < 10) {
            const int tn = tn_all - 6, row0 = tm * 128, col0 = tn * 128;
            const bf16_t* A = P + (size_t)row0 * PW + PC_CKV;
            row_rstd(A, PW, 128, rs, tid);
            f32x4 acc[4][4]; zero_acc<4, 4>(acc);
            { int par0 = 0; gemm_core<128, true>(A, PW, (const bf16_t*)(p.ws + OFF_WUK) + (size_t)col0 * 128, 128, 128, acc, lds, tid, par0); }
#pragma unroll
            for (int m = 0; m < 4; ++m) {
                const int rl = wr * 64 + m * 16 + c, row = row0 + rl;
                const float sc = rs[rl];
#pragma unroll
                for (int n = 0; n < 4; ++n) {
                    const f32x4 v = acc[m][n] * sc;
                    u32x2 w; w.x = pack2(v[0], v[1]); w.y = pack2(v[2], v[3]);
                    *(u32x2*)(KB + (size_t)row * 768 + tn * 192 + wc * 64 + n * 16 + 4 * g) = w;
                }
            }
        } else {
            const int tn = tn_all - 10, row0 = tm * 128, col0 = tn * 128;
            const bf16_t* A = P + (size_t)row0 * PW + PC_CKV;
            row_rstd(A, PW, 128, rs, tid);
            f32x4 acc[4][4]; zero_acc<4, 4>(acc);
            { int par0 = 0; gemm_core<128, false>(A, PW, (const bf16_t*)(p.ws + OFF_WUV) + (size_t)col0 * 128, 128, 128, acc, lds, tid, par0); }
#pragma unroll
            for (int m = 0; m < 4; ++m) {
                const int rl = wr * 64 + m * 16 + 4 * g, rowb = row0 + rl;
                const int b = rowb / TU, t = rowb - b * TU;
                const float s0 = rs[rl], s1 = rs[rl + 1], s2 = rs[rl + 2], s3 = rs[rl + 3];
#pragma unroll
                for (int n = 0; n < 4; ++n) {
                    u32x2 w; w.x = pack2(acc[m][n][0] * s0, acc[m][n][1] * s1); w.y = pack2(acc[m][n][2] * s2, acc[m][n][3] * s3);
                    *(u32x2*)((bf16_t*)(p.ws + OFF_VTB) + ((size_t)((b * 4 + tn) * 128 + wc * 64 + n * 16 + c)) * TU + t) = w;
                }
            }
        }
    }
}

template <int DQK, int DV, int KT, bool WIN, int LDQ, int LDK, int LDO>
__device__ __forceinline__ void attn_item(const bf16_t* Qp, const bf16_t* __restrict__ Kp, const bf16_t* __restrict__ Vt, bf16_t* Op,
                          int seg0_start, int seg0_tiles, int seg1_start, int seg1_tiles, int qpos0,
                          float m_init, float l_init, char* lds, int tid) {
    constexpr int KS = DQK / 32, DT = DV / 16, NSUB = DQK / 64, NKT = KT / 16, NGRP = KT / 32;
    constexpr int KP = KT * 8 / 256;
    constexpr int NVC = DV * (KT / 8) / 256;
    constexpr int KROW = DQK * 2;
    const int lane = tid & 63, w = tid >> 6, g = lane >> 4, c = lane & 15;
    char* Ks = lds;
    char* Vs = lds + KT * KROW;
    bf16x8 qf[2][KS];
#pragma unroll
    for (int qt = 0; qt < 2; ++qt)
#pragma unroll
        for (int ks = 0; ks < KS; ++ks) qf[qt][ks] = *(const bf16x8*)(Qp + (size_t)(w * 32 + qt * 16 + c) * LDQ + ks * 32 + 8 * g);
    f32x4 O[DT][2];
#pragma unroll
    for (int dt = 0; dt < DT; ++dt) { O[dt][0] = (f32x4){0.f, 0.f, 0.f, 0.f}; O[dt][1] = (f32x4){0.f, 0.f, 0.f, 0.f}; }
    constexpr bool FOLD = FOLD_ALL || (DQK == 64 && DV == 128);
    constexpr bool LSUM = true;
    float mrun[2] = {m_init, m_init};
    float lrun[2] = {g == 0 ? l_init : 0.f, g == 0 ? l_init : 0.f};
    f32x4 OL[2] = {(f32x4){l_init, l_init, l_init, l_init}, (f32x4){l_init, l_init, l_init, l_init}};

    const int ntiles = seg0_tiles + seg1_tiles;
    const int st_r = tid >> 3, st_cc = tid & 7;
    const bf16_t* kg_base = Kp + (size_t)st_r * LDK + st_cc * 8;
    char* kl_base = Ks + st_r * KROW + ((st_cc ^ (st_r & 7)) << 4);
    const bf16_t* vg_base; char* vl_base;
    if (KT == 64) { vg_base = Vt + (size_t)(tid >> 3) * TU + (tid & 7) * 8; vl_base = Vs + (tid >> 3) * 128 + (((tid & 7) ^ ((tid >> 3) & 7)) << 4); }
    else          { vg_base = Vt + (size_t)(tid >> 2) * TU + (tid & 3) * 8; vl_base = Vs + (tid >> 2) * 64 + (((tid & 3) ^ ((tid >> 4) & 3)) << 4); }
    const char* kf_base = Ks + (8 * (c >> 2) + (c & 3)) * KROW + ((g ^ (c & 3)) << 4);
    const char* vf_base0; const char* vf_base1;
    if (KT == 64) { vf_base0 = Vs + c * 128 + ((0 ^ ((c >> 2) & 1)) << 6) + ((g ^ (c & 3)) << 4); vf_base1 = Vs + c * 128 + ((1 ^ ((c >> 2) & 1)) << 6) + ((g ^ (c & 3)) << 4); }
    else          { vf_base0 = Vs + c * 64 + ((g ^ ((c >> 2) & 3)) << 4); vf_base1 = vf_base0; }
    u32x4 kreg[NSUB * KP], vreg[NVC];
    auto gload_k = [&](int ti) {
        const int key0 = ti < seg0_tiles ? seg0_start + KT * ti : seg1_start + KT * (ti - seg0_tiles);
        const bf16_t* kp = kg_base + (size_t)key0 * LDK;
#pragma unroll
        for (int sub = 0; sub < NSUB; ++sub)
#pragma unroll
            for (int i = 0; i < KP; ++i) kreg[sub * KP + i] = *(const u32x4*)(kp + (size_t)i * 32 * LDK + sub * 64);
    };
    auto gload_v = [&](int ti) {
        const int key0 = ti < seg0_tiles ? seg0_start + KT * ti : seg1_start + KT * (ti - seg0_tiles);
        const bf16_t* vp = vg_base + key0;
#pragma unroll
        for (int i = 0; i < NVC; ++i) vreg[i] = *(const u32x4*)(vp + (size_t)i * (KT == 64 ? 32 : 64) * TU);
    };
    auto gload = [&](int ti) { gload_k(ti); gload_v(ti); };
    auto lstore = [&]() {
#pragma unroll
        for (int sub = 0; sub < NSUB; ++sub)
#pragma unroll
            for (int i = 0; i < KP; ++i) *(u32x4*)(kl_base + i * 32 * KROW + sub * 128) = kreg[sub * KP + i];
#pragma unroll
        for (int i = 0; i < NVC; ++i) *(u32x4*)(vl_base + i * 4096) = vreg[i];
    };
    if (ntiles > 0) gload(0);
    for (int ti = 0; ti < ntiles; ++ti) {
        __syncthreads();
        lstore();
        __syncthreads();
        if (KS <= 2 && ti + 1 < ntiles) gload(ti + 1);
        f32x4 S[NKT][2];
        const float nb0 = (!FOLD || mrun[0] < -1e29f) ? 0.f : -mrun[0], nb1 = (!FOLD || mrun[1] < -1e29f) ? 0.f : -mrun[1];
#pragma unroll
        for (int kt = 0; kt < NKT; ++kt) { S[kt][0] = (f32x4){nb0, nb0, nb0, nb0}; S[kt][1] = (f32x4){nb1, nb1, nb1, nb1}; }
#pragma unroll
        for (int ks = 0; ks < KS; ++ks) {
#pragma unroll
            for (int kt = 0; kt < NKT; ++kt) {
                const bf16x8 kf = *(const bf16x8*)(kf_base + (32 * (kt >> 1) + 4 * (kt & 1)) * KROW + (ks >> 1) * 128 + (((ks & 1) ^ (kt & 1)) << 6));
                S[kt][0] = __builtin_amdgcn_mfma_f32_16x16x32_bf16(kf, qf[0][ks], S[kt][0], 0, 0, 0);
                S[kt][1] = __builtin_amdgcn_mfma_f32_16x16x32_bf16(kf, qf[1][ks], S[kt][1], 0, 0, 0);
            }
        }
        if (KS > 2 && ti + 1 < ntiles) gload_k(ti + 1);
        if (WIN && ti < seg0_tiles) {
            const int key0 = seg0_start + KT * ti;
#pragma unroll
            for (int qt = 0; qt < 2; ++qt) {
                const int qp = qpos0 + w * 32 + qt * 16 + c;
#pragma unroll
                for (int kt = 0; kt < NKT; ++kt)
#pragma unroll
                    for (int r = 0; r < 4; ++r) {
                        const int kp = key0 + 32 * (kt >> 1) + 8 * g + 4 * (kt & 1) + r;
                        const int d = kp - qp;
                        if (d > 128 || d < -128) S[kt][qt][r] = -1e30f;
                    }
            }
        }
        bf16x8 pf[2][NGRP];
#pragma unroll
        for (int qt = 0; qt < 2; ++qt) {
            float mx = S[0][qt][0];
#pragma unroll
            for (int kt = 0; kt < NKT; ++kt)
#pragma unroll
                for (int r = 0; r < 4; ++r) mx = fmaxf(mx, S[kt][qt][r]);
            mx = rows_max(mx);
            const float base = FOLD ? (qt ? -nb1 : -nb0) : 0.f;
            if (!__all(base + mx <= mrun[qt] + 8.0f)) {
                const float mnew = fmaxf(mrun[qt], base + mx);
                const float alpha = __builtin_amdgcn_exp2f(mrun[qt] - mnew);
                mrun[qt] = mnew;
                if (LSUM) OL[qt] = OL[qt] * alpha; else lrun[qt] *= alpha;
#pragma unroll
                for (int dt = 0; dt < DT; ++dt) O[dt][qt] = O[dt][qt] * alpha;
                if (FOLD) {
                    const float delta = mnew - base;
#pragma unroll
                    for (int kt = 0; kt < NKT; ++kt)
#pragma unroll
                        for (int r = 0; r < 4; ++r) S[kt][qt][r] -= delta;
                }
            }
            const float mcur = FOLD ? 0.f : mrun[qt];
            float ps = 0.f;
#pragma unroll
            for (int kt = 0; kt < NKT; ++kt)
#pragma unroll
                for (int r = 0; r < 4; ++r) { const float e = __builtin_amdgcn_exp2f(S[kt][qt][r] - mcur); S[kt][qt][r] = e; if (!LSUM) ps += e; }
            if (!LSUM) lrun[qt] += ps;
#pragma unroll
            for (int grp = 0; grp < NGRP; ++grp) {
                u32x4 pk;
                pk.x = pack2(S[2 * grp][qt][0], S[2 * grp][qt][1]); pk.y = pack2(S[2 * grp][qt][2], S[2 * grp][qt][3]);
                pk.z = pack2(S[2 * grp + 1][qt][0], S[2 * grp + 1][qt][1]); pk.w = pack2(S[2 * grp + 1][qt][2], S[2 * grp + 1][qt][3]);
                pf[qt][grp] = __builtin_bit_cast(bf16x8, pk);
            }
        }
        if (KS > 2 && ti + 1 < ntiles) gload_v(ti + 1);
#pragma unroll
        for (int dt = 0; dt < DT; ++dt)
#pragma unroll
            for (int grp = 0; grp < NGRP; ++grp) {
                const bf16x8 vf = *(const bf16x8*)((grp ? vf_base1 : vf_base0) + dt * 16 * (KT * 2));
                O[dt][0] = __builtin_amdgcn_mfma_f32_16x16x32_bf16(vf, pf[0][grp], O[dt][0], 0, 0, 0);
                O[dt][1] = __builtin_amdgcn_mfma_f32_16x16x32_bf16(vf, pf[1][grp], O[dt][1], 0, 0, 0);
            }
        if (LSUM) {
            unsigned one2 = 0x3F803F80u;
            asm volatile("" : "+v"(one2));
            const bf16x8 ones8 = __builtin_bit_cast(bf16x8, (u32x4){one2, one2, one2, one2});
#pragma unroll
            for (int grp = 0; grp < NGRP; ++grp) {
                OL[0] = __builtin_amdgcn_mfma_f32_16x16x32_bf16(ones8, pf[0][grp], OL[0], 0, 0, 0);
                OL[1] = __builtin_amdgcn_mfma_f32_16x16x32_bf16(ones8, pf[1][grp], OL[1], 0, 0, 0);
            }
        }
    }
#pragma unroll
    for (int qt = 0; qt < 2; ++qt) {
        float lt;
        if (LSUM) lt = OL[qt][0];
        else lt = rows_sum(lrun[qt]);
        const float inv = 1.0f / lt;
        bf16_t* op = Op + (size_t)(w * 32 + qt * 16 + c) * LDO + 4 * g;
#pragma unroll
        for (int dt = 0; dt < DT; ++dt) {
            const f32x4 o = O[dt][qt] * inv;
            u32x2 wv; wv.x = pack2(o[0], o[1]); wv.y = pack2(o[2], o[3]);
            *(u32x2*)(op + dt * 16) = wv;
        }
    }
}

#define HG_BUF 33280
__device__ __forceinline__ unsigned rot16(unsigned x) { return (x >> 16) | (x << 16); }

__device__ __forceinline__ void hgrn_item(const DP& p, int item, bool store_ctx, char* lds, int tid) {
    const int b = item >> 3, h = (item >> 1) & 3, dir = item & 1;
    const int lane = tid & 63, w = tid >> 6, g = lane >> 4, c = lane & 15;
    const bf16_t* HT = (const bf16_t*)(p.ws + OFF_HT) + (size_t)((b * 4 + h) * 4) * 128 * TU;
    const int ch = tid >> 1, half = tid & 1;
    const bf16_t* qrow = HT + (size_t)ch * TU;
    const bf16_t* krow = HT + (size_t)((1 + dir) * 128 + ch) * TU;
    const bf16_t* vrow = HT + (size_t)(3 * 128 + ch) * TU;
    bf16_t* Og = dir ? (bf16_t*)(p.ws + OFF_OHB) + (size_t)b * TU * 512 + h * 128 : (bf16_t*)(p.ws + OFF_P) + (size_t)b * TU * PW + PC_HOH + h * 128;
    const int ldo = dir ? 512 : PW;
    const int pch = (ch & ~31) | (((ch >> 2) & 3) << 3) | (((ch >> 4) & 1) << 2) | (ch & 3);
    const int q_wr = (pch & 7) * 2;
    const int q_chk = pch >> 3;
    const int kh_wr = ch * 64 + 8 * half;
    const int sw = (ch >> 1) & 3;
    int qk_rd[4];
#pragma unroll
    for (int ks = 0; ks < 4; ++ks) qk_rd[ks] = c * 256 + ((ks ^ (c >> 2)) << 6) + ((g ^ (c & 3)) << 4);
    const int kh_rd = 16384 + c * 64 + ((g ^ ((c >> 1) & 3)) << 4);
    const int vt_rd = 24576 + (32 * w + c) * 64 + ((g ^ ((c >> 1) & 3)) << 4);
    const int d_rd = 32768 + 16 * g;

    f32x4 S[8][2];
#pragma unroll
    for (int kt = 0; kt < 8; ++kt) { S[kt][0] = (f32x4){0.f, 0.f, 0.f, 0.f}; S[kt][1] = (f32x4){0.f, 0.f, 0.f, 0.f}; }

    u32x4 lq0, lq1, lk0, lk1, lv0, lv1;
    auto chunk_base = [&](int j) -> int {
        if (!dir) return j < 8 ? SEQ + 32 * j : 32 * (j - 8);
        return j < 8 ? SEQ + CTXL - 32 * (j + 1) : SEQ - 32 * (j - 7);
    };
    auto gload = [&](int j) {
        const int off = chunk_base(j) + (dir ? 16 * (1 - half) : 16 * half);
        lq0 = *(const u32x4*)(qrow + off); lq1 = *(const u32x4*)(qrow + off + 8);
        lk0 = *(const u32x4*)(krow + off); lk1 = *(const u32x4*)(krow + off + 8);
        lv0 = *(const u32x4*)(vrow + off); lv1 = *(const u32x4*)(vrow + off + 8);
    };
    auto prep = [&](char* B) {
        unsigned qw[8] = {lq0.x, lq0.y, lq0.z, lq0.w, lq1.x, lq1.y, lq1.z, lq1.w};
        unsigned kw[8] = {lk0.x, lk0.y, lk0.z, lk0.w, lk1.x, lk1.y, lk1.z, lk1.w};
        unsigned vw[8] = {lv0.x, lv0.y, lv0.z, lv0.w, lv1.x, lv1.y, lv1.z, lv1.w};
        if (dir) {
#pragma unroll
            for (int d = 0; d < 4; ++d) {
                unsigned t0 = rot16(qw[7 - d]); qw[7 - d] = rot16(qw[d]); qw[d] = t0;
                unsigned t1 = rot16(kw[7 - d]); kw[7 - d] = rot16(kw[d]); kw[d] = t1;
                unsigned t2 = rot16(vw[7 - d]); vw[7 - d] = rot16(vw[d]); vw[d] = t2;
            }
        }
        float bc[16]; float run = 0.f;
#pragma unroll
        for (int i = 0; i < 16; ++i) {
            const float kv = (i & 1) ? bfhi(kw[i >> 1]) : bflo(kw[i >> 1]);
            run += fmaxf(__builtin_amdgcn_logf(1.0f - kv), -126.0f);
            bc[i] = run;
        }
        const float oth = __shfl_xor(run, 1);
        const float bend = run + oth;
        const float add = half ? oth : 0.f;
        unsigned khw[8];
#pragma unroll
        for (int i = 0; i < 16; i += 2) {
            float qt[2], kt2[2], kh2[2];
#pragma unroll
            for (int e = 0; e < 2; ++e) {
                const float bb = bc[i + e] + add;
                const float bcl = fmaxf(bb, -120.0f);
                const float qv = e ? bfhi(qw[i >> 1]) : bflo(qw[i >> 1]);
                const float kv = e ? bfhi(kw[i >> 1]) : bflo(kw[i >> 1]);
                qt[e] = qv * __builtin_amdgcn_exp2f(bcl);
                kt2[e] = kv * __builtin_amdgcn_exp2f(-bcl);
                kh2[e] = kv * __builtin_amdgcn_exp2f(bend - bb);
                const int tau = 16 * half + i + e;
                const int a = tau * 256 + ((q_chk ^ (tau & 15)) << 4) + q_wr;
                *(bf16_t*)(B + a) = (bf16_t)f2bf(qt[e]);
                *(bf16_t*)(B + 8192 + a) = (bf16_t)f2bf(kt2[e]);
            }
            khw[i >> 1] = pack2(kh2[0], kh2[1]);
        }
#pragma unroll
        for (int gq = 0; gq < 4; ++gq) {
            u32x2 a; a.x = khw[2 * gq]; a.y = khw[2 * gq + 1];
            *(u32x2*)(B + 16384 + kh_wr + ((gq ^ sw) << 4)) = a;
            u32x2 v2; v2.x = vw[2 * gq]; v2.y = vw[2 * gq + 1];
            *(u32x2*)(B + 24576 + kh_wr + ((gq ^ sw) << 4)) = v2;
        }
        if (half == 0) *(float*)(B + 32768 + ch * 4) = __builtin_amdgcn_exp2f(bend);
    };

    __syncthreads();
    gload(0);
    prep(lds);
    __syncthreads();
    const int NCH = TU / 32;
    for (int j = 0; j < NCH; ++j) {
        const char* B = lds + (j & 1) * HG_BUF;
        if (j + 1 < NCH) gload(j + 1);
        f32x4 a00 = {0.f, 0.f, 0.f, 0.f}, a01 = {0.f, 0.f, 0.f, 0.f}, a11 = {0.f, 0.f, 0.f, 0.f};
        f32x4 o[2][2];
        o[0][0] = o[0][1] = o[1][0] = o[1][1] = (f32x4){0.f, 0.f, 0.f, 0.f};
#pragma unroll
        for (int ks = 0; ks < 4; ++ks) {
            const bf16x8 q0 = *(const bf16x8*)(B + qk_rd[ks]), q1 = *(const bf16x8*)(B + qk_rd[ks] + 4096);
            const bf16x8 k0 = *(const bf16x8*)(B + 8192 + qk_rd[ks]), k1 = *(const bf16x8*)(B + 8192 + qk_rd[ks] + 4096);
            a00 = __builtin_amdgcn_mfma_f32_16x16x32_bf16(k0, q0, a00, 0, 0, 0);
            a01 = __builtin_amdgcn_mfma_f32_16x16x32_bf16(k0, q1, a01, 0, 0, 0);
            a11 = __builtin_amdgcn_mfma_f32_16x16x32_bf16(k1, q1, a11, 0, 0, 0);
#pragma unroll
            for (int nv = 0; nv < 2; ++nv) {
                u32x4 sb;
                sb.x = pack2(S[2 * ks][nv][0], S[2 * ks][nv][1]); sb.y = pack2(S[2 * ks][nv][2], S[2 * ks][nv][3]);
                sb.z = pack2(S[2 * ks + 1][nv][0], S[2 * ks + 1][nv][1]); sb.w = pack2(S[2 * ks + 1][nv][2], S[2 * ks + 1][nv][3]);
                const bf16x8 sbf = __builtin_bit_cast(bf16x8, sb);
                o[0][nv] = __builtin_amdgcn_mfma_f32_16x16x32_bf16(q0, sbf, o[0][nv], 0, 0, 0);
                o[1][nv] = __builtin_amdgcn_mfma_f32_16x16x32_bf16(q1, sbf, o[1][nv], 0, 0, 0);
            }
        }
#pragma unroll
        for (int r = 0; r < 4; ++r) { if (4 * g + r > c) { a00[r] = 0.f; a11[r] = 0.f; } }
        u32x4 pa0, pa1;
        pa0.x = pack2(a00[0], a00[1]); pa0.y = pack2(a00[2], a00[3]); pa0.z = 0u; pa0.w = 0u;
        pa1.x = pack2(a01[0], a01[1]); pa1.y = pack2(a01[2], a01[3]); pa1.z = pack2(a11[0], a11[1]); pa1.w = pack2(a11[2], a11[3]);
        const bf16x8 vt0 = *(const bf16x8*)(B + vt_rd), vt1 = *(const bf16x8*)(B + vt_rd + 1024);
        o[0][0] = __builtin_amdgcn_mfma_f32_16x16x32_bf16(__builtin_bit_cast(bf16x8, pa0), vt0, o[0][0], 0, 0, 0);
        o[0][1] = __builtin_amdgcn_mfma_f32_16x16x32_bf16(__builtin_bit_cast(bf16x8, pa0), vt1, o[0][1], 0, 0, 0);
        o[1][0] = __builtin_amdgcn_mfma_f32_16x16x32_bf16(__builtin_bit_cast(bf16x8, pa1), vt0, o[1][0], 0, 0, 0);
        o[1][1] = __builtin_amdgcn_mfma_f32_16x16x32_bf16(__builtin_bit_cast(bf16x8, pa1), vt1, o[1][1], 0, 0, 0);
#pragma unroll
        for (int kt = 0; kt < 8; ++kt) {
            const f32x4 dv = *(const f32x4*)(B + d_rd + kt * 64);
            const bf16x8 khf = *(const bf16x8*)(B + kh_rd + kt * 1024);
            S[kt][0] = __builtin_amdgcn_mfma_f32_16x16x32_bf16(khf, vt0, S[kt][0] * dv, 0, 0, 0);
            S[kt][1] = __builtin_amdgcn_mfma_f32_16x16x32_bf16(khf, vt1, S[kt][1] * dv, 0, 0, 0);
        }
        {
            const int base = chunk_base(j);
#pragma unroll
            for (int tt = 0; tt < 2; ++tt)
#pragma unroll
                for (int r = 0; r < 4; ++r) {
                    const int tau = 16 * tt + 4 * g + r;
                    const int tok = dir ? base + 31 - tau : base + tau;
                    if (store_ctx || tok < SEQ) {
                        bf16_t* op = Og + (size_t)tok * ldo + 32 * w + c;
                        op[0] = (bf16_t)f2bf(o[tt][0][r]);
                        op[16] = (bf16_t)f2bf(o[tt][1][r]);
                    }
                }
        }
        if (j + 1 < NCH) prep(lds + ((j + 1) & 1) * HG_BUF);
        __syncthreads();
    }
}

#define QCTR_WORD(l) (3520 + 64 * (l))
__device__ __forceinline__ void phase_mixers(const DP& p, int l, char* lds, int tid, int mask) {
    const int nqb = (l == 0) ? 18 : 16;
    const int nBi = NB * 4 * nqb, nAi = NB * 8 * nqb, nDi = NB * 8 * nqb;
    if (mask & 1) for (int it = p.bid; it < 64; it += p.nblk) hgrn_item(p, it, l == 0, lds, tid);
    if (mask & 14) {
        unsigned* ctr = (unsigned*)(p.ws + OFF_BAR) + QCTR_WORD(l) + (mask == 15 ? 0 : 16);
        volatile int* slot = (volatile int*)(lds + LDS_MISC + 992);
        for (;;) {
            __syncthreads();
            if (tid == 0) *slot = (int)atomicAdd(ctr, 1u);
            __syncthreads();
            int it = *slot;
            int tl = tid;
            asm volatile("" : "+v"(tl));
            if (mask != 15) { if (!(mask & 2)) it += nBi; if (it >= nBi && !(mask & 4)) it = nBi + nAi + nDi; if (!(mask & 8) && it >= nBi + nAi) it = nBi + nAi + nDi; }
            if (it >= nBi + nAi + nDi) break;
            if (it < nBi) {
                const int j = it;
                const int qb = j % nqb, h = (j / nqb) & 3, b = j / (nqb * 4);
                const int tok0 = qb < 16 ? qb * 128 : SEQ + (qb - 16) * 128;
                const size_t rowq = (size_t)b * TU + tok0;
                attn_item<192, 128, BKT, false, 768, 768, 512>((const bf16_t*)(p.ws + OFF_QB) + rowq * 768 + h * 192,
                                           (const bf16_t*)(p.ws + OFF_KB) + (size_t)b * TU * 768 + h * 192,
                                           (const bf16_t*)(p.ws + OFF_VTB) + (size_t)(b * 4 + h) * 128 * TU,
                                           (bf16_t*)(p.ws + OFF_OB) + rowq * 512 + h * 128,
                                           0, 0, qb < 16 ? 0 : SEQ, (qb < 16 ? TU : CTXL) / BKT, 0, -1e30f, 0.f, lds, tl);
            } else if (it < nBi + nAi) {
                const int j = it - nBi;
                const bf16_t* P = (const bf16_t*)(p.ws + OFF_P);
                const int qb = j % nqb, hs = (j / nqb) & 7, b = j / (nqb * 8);
                const int h = hs >> 1, sidx = hs & 1;
                const int tok0 = qb < 16 ? qb * 128 : SEQ + (qb - 16) * 128;
                const size_t rowq = (size_t)b * TU + tok0;
                attn_item<64, 128, 64, false, PW, PW, 1024>(P + rowq * PW + PC_AQ + h * 128 + sidx * 64,
                                          P + (size_t)b * TU * PW + (sidx ? PC_AK2 : PC_AK1) + h * 64,
                                          (const bf16_t*)(p.ws + OFF_VTA) + (size_t)(b * 4 + h) * 128 * TU,
                                          (bf16_t*)(p.ws + OFF_OA12) + rowq * 1024 + hs * 128,
                                          0, 0, qb < 16 ? 0 : SEQ, qb < 16 ? 36 : 4, 0, -1e30f, 0.f, lds, tl);
            } else {
                const int j = it - nBi - nAi;
                const bf16_t* P = (const bf16_t*)(p.ws + OFF_P);
                const int qb = j % nqb, hq = (j / nqb) & 7, b = j / (nqb * 8);
                const int tok0 = qb < 16 ? qb * 128 : SEQ + (qb - 16) * 128;
                const size_t rowq = (size_t)b * TU + tok0;
                int s0 = 0, n0 = 0;
                if (qb < 16) { s0 = qb * 128 - 128; if (s0 < 0) s0 = 0; int e0 = qb * 128 + 256; if (e0 > SEQ) e0 = SEQ; n0 = (e0 - s0) >> 6; }
                const float sink = p.in[I_SINK][l * 8 + hq] * LOG2E;
                bf16_t* qo = (bf16_t*)(p.ws + OFF_P) + rowq * PW + PC_DQ + hq * 64;
                attn_item<64, 64, 64, true, PW, PW, PW>(qo, P + (size_t)b * TU * PW + PC_DK + (hq >> 2) * 64,
                                        (const bf16_t*)(p.ws + OFF_VTD) + (size_t)(b * 2 + (hq >> 2)) * 64 * TU,
                                        qo, s0, n0, SEQ, 4, tok0, sink, 1.0f, lds, tl);
            }
        }
    }
}

__device__ __forceinline__ void phase_convq(const DP& p, int l, char* lds, int tid) {
    unsigned* ctr2 = (unsigned*)(p.ws + OFF_BAR) + QCTR_WORD(l) + 32;
    volatile int* slot = (volatile int*)(lds + LDS_MISC + 992);
    for (;;) {
        __syncthreads();
        if (tid == 0) *slot = (int)atomicAdd(ctr2, 1u);
        __syncthreads();
        const int it = *slot;
        if (it >= NCONV) break;
        int tl = tid;
        asm volatile("" : "+v"(tl));
        conv_tables_item(p, l, it, tl);
    }
}

__device__ __forceinline__ void phase_combine(const DP& p, int l, int tid) {
    const int lane = tid & 63;
    const int gw = p.bid * 4 + (tid >> 6), nw = p.nblk * 4;
    const float lam = ((const float*)(p.ws + OFF_LAM))[l * 2 + 0], lam_init = ((const float*)(p.ws + OFF_LAM))[l * 2 + 1];
    const int h = lane >> 4, d0 = (lane & 15) * 8;
    const float* dng = p.in[I_DNG] + l * 128 + d0;
    const float* hng = p.in[I_HNG] + l * 128 + d0;
    bf16_t* P = (bf16_t*)(p.ws + OFF_P);
    const bf16_t* OA = (const bf16_t*)(p.ws + OFF_OA12);
    const bf16_t* OBk = (const bf16_t*)(p.ws + OFF_OHB);
    for (int row = gw; row < RR; row += nw) {
        const int t = row % TU;
        if (l == 1 && t >= SEQ) continue;
        {
            const u32x4 a = *(const u32x4*)(OA + (size_t)row * 1024 + (h * 2 + 0) * 128 + d0);
            const u32x4 bq = *(const u32x4*)(OA + (size_t)row * 1024 + (h * 2 + 1) * 128 + d0);
            float o[8]; float ss = 0.f;
#pragma unroll
            for (int i = 0; i < 4; ++i) { o[2 * i] = bflo(a[i]) - lam * bflo(bq[i]); o[2 * i + 1] = bfhi(a[i]) - lam * bfhi(bq[i]); }
#pragma unroll
            for (int i = 0; i < 8; ++i) ss += o[i] * o[i];
            ss += __shfl_xor(ss, 1); ss += __shfl_xor(ss, 2); ss += __shfl_xor(ss, 4); ss += __shfl_xor(ss, 8);
            const float rstd = rsqrtf(ss * (1.0f / 128.0f) + 1e-6f) * (1.0f - lam_init);
            u32x4 w;
            w.x = pack2(o[0] * rstd * dng[0], o[1] * rstd * dng[1]); w.y = pack2(o[2] * rstd * dng[2], o[3] * rstd * dng[3]);
            w.z = pack2(o[4] * rstd * dng[4], o[5] * rstd * dng[5]); w.w = pack2(o[6] * rstd * dng[6], o[7] * rstd * dng[7]);
            *(u32x4*)(P + (size_t)row * PW + PC_AQ + h * 128 + d0) = w;
        }
        {
            const u32x4 a = *(const u32x4*)(P + (size_t)row * PW + PC_HOH + h * 128 + d0);
            const u32x4 bq = *(const u32x4*)(OBk + (size_t)row * 512 + h * 128 + d0);
            const u32x4 gg = *(const u32x4*)(P + (size_t)row * PW + PC_HG + h * 128 + d0);
            float o[8], gt[8]; float ss = 0.f;
#pragma unroll
            for (int i = 0; i < 4; ++i) { o[2 * i] = bflo(a[i]) + bflo(bq[i]); o[2 * i + 1] = bfhi(a[i]) + bfhi(bq[i]); gt[2 * i] = bflo(gg[i]); gt[2 * i + 1] = bfhi(gg[i]); }
#pragma unroll
            for (int i = 0; i < 8; ++i) ss += o[i] * o[i];
            ss += __shfl_xor(ss, 1); ss += __shfl_xor(ss, 2); ss += __shfl_xor(ss, 4); ss += __shfl_xor(ss, 8);
            const float rstd = rsqrtf(ss * (1.0f / 128.0f) + 1e-6f);
            float y[8];
#pragma unroll
            for (int i = 0; i < 8; ++i) y[i] = o[i] * rstd * hng[i] * siluf_(gt[i]);
            u32x4 w; w.x = pack2(y[0], y[1]); w.y = pack2(y[2], y[3]); w.z = pack2(y[4], y[5]); w.w = pack2(y[6], y[7]);
            *(u32x4*)(P + (size_t)row * PW + PC_HOH + h * 128 + d0) = w;
        }
    }
}

__device__ __forceinline__ void merge_branch_src(const DP& p, int j, int row0, const bf16_t*& A, int& lda) {
    const bf16_t* P = (const bf16_t*)(p.ws + OFF_P);
    if (j == 0) { A = P + (size_t)row0 * PW + PC_AQ; lda = PW; }
    else if (j == 1) { A = (const bf16_t*)(p.ws + OFF_OB) + (size_t)row0 * 512; lda = 512; }
    else if (j == 2) { A = P + (size_t)row0 * PW + PC_HOH; lda = PW; }
    else { A = P + (size_t)row0 * PW + PC_DQ; lda = PW; }
}
__device__ __forceinline__ void phase_merge(const DP& p, int l, char* lds, int tid) {
    const int lane = tid & 63, wid = tid >> 6, wr = wid >> 1, wc = wid & 1, g = lane >> 4, c = lane & 15;
    const bf16_t* HX = (const bf16_t*)(p.ws + OFF_HX);
    bf16_t* Y = (bf16_t*)(p.ws + OFF_Y);
    const bf16_t* WG = (const bf16_t*)(p.ws + OFF_WG);
    const bf16_t* WBR = (const bf16_t*)(p.ws + OFF_WBR);
    TileIter ti;
    if (l == DEPTH_ - 1) ti.init(p, 8, 4, 128); else ti.init(p, 8, 6);
    int tm, tn, tmn, tnn;
    bool have = false, haven = false;
    auto fetch = [&](int& a_tm, int& a_tn) -> bool { if (!ti.next(a_tm, a_tn)) return false; if (l == DEPTH_ - 1) a_tm = (a_tm >> 4) * 18 + (a_tm & 15); return true; };
    have = fetch(tm, tn);
    int par = 0; bool pre = false;
    while (have) {
        haven = fetch(tmn, tnn);
        const int row0 = tm * 128, col0 = tn * 128;
        u32x2 y[4][4];
#pragma unroll
        for (int m = 0; m < 4; ++m)
#pragma unroll
            for (int n = 0; n < 4; ++n) { y[m][n].x = 0u; y[m][n].y = 0u; }
#pragma unroll 1
        for (int j = 0; j < 4; ++j) {
            const bf16_t* Ab; int ldab; merge_branch_src(p, j, row0, Ab, ldab);
            const bf16_t* Bb = WBR + (size_t)j * 1024 * 512 + (size_t)col0 * 512;
            u32x2 sg[4][4];
            {
                f32x4 ag[4][4]; zero_acc<4, 4>(ag);
                gemm_core<128, true>(HX + (size_t)row0 * DM, DM, WG + (size_t)(j * 1024 + col0) * DM, DM, DM, ag, lds, tid, par, pre, Ab, ldab, Bb, 512);
#pragma unroll
                for (int m = 0; m < 4; ++m)
#pragma unroll
                    for (int n = 0; n < 4; ++n) {
                        float sv[4];
#pragma unroll
                        for (int r = 0; r < 4; ++r) sv[r] = 1.0f / (1.0f + __expf(-ag[m][n][r]));
                        sg[m][n].x = pack2(sv[0], sv[1]); sg[m][n].y = pack2(sv[2], sv[3]);
                    }
            }
            const bf16_t* An = nullptr; const bf16_t* Bn = nullptr;
            if (j < 3) { An = HX + (size_t)row0 * DM; Bn = WG + (size_t)((j + 1) * 1024 + col0) * DM; }
            else if (haven) { An = HX + (size_t)(tmn * 128) * DM; Bn = WG + (size_t)(tnn * 128) * DM; }
            f32x4 ab[4][4]; zero_acc<4, 4>(ab);
            gemm_core<128, true>(Ab, ldab, Bb, 512, 512, ab, lds, tid, par, true, An, DM, Bn, DM);
            pre = (An != nullptr);
#pragma unroll
            for (int m = 0; m < 4; ++m)
#pragma unroll
                for (int n = 0; n < 4; ++n) {
                    const float y0 = bflo(y[m][n].x) + ab[m][n][0] * bflo(sg[m][n].x), y1 = bfhi(y[m][n].x) + ab[m][n][1] * bfhi(sg[m][n].x);
                    const float y2 = bflo(y[m][n].y) + ab[m][n][2] * bflo(sg[m][n].y), y3 = bfhi(y[m][n].y) + ab[m][n][3] * bfhi(sg[m][n].y);
                    y[m][n].x = pack2(y0, y1); y[m][n].y = pack2(y2, y3);
                }
        }
#pragma unroll
        for (int m = 0; m < 4; ++m) {
            const int row = row0 + wr * 64 + m * 16 + c;
#pragma unroll
            for (int n = 0; n < 4; ++n)
                *(u32x2*)(Y + (size_t)row * DM + col0 + wc * 64 + n * 16 + 4 * g) = y[m][n];
        }
        have = haven; tm = tmn; tn = tnn;
    }
}

__device__ __forceinline__ void phase_wout(const DP& p, int l, char* lds, int tid) {
    const int lane = tid & 63, wid = tid >> 6, wr = wid >> 1, wc = wid & 1, g = lane >> 4, c = lane & 15;
    const bf16_t* Y = (const bf16_t*)(p.ws + OFF_Y);
    float* X = (float*)(p.ws + OFF_X);
    const float* mod = (const float*)(p.ws + OFF_MOD) + (size_t)l * 9 * 6144;
    TileIter ti;
    if (l == DEPTH_ - 1) ti.init(p, 8, 8, 64); else ti.init(p, 8, 9, 72);
    int tm, tn;
    while (ti.next(tm, tn)) {
        if (l == DEPTH_ - 1) tm = (tm >> 3) * 9 + (tm & 7);
        const int row0 = tm * 256, col0 = tn * 128;
        const bool isctx = (tm % 9) == 8;
        f32x4 acc[8][4]; zero_acc<8, 4>(acc);
        gemm256<true>(Y + (size_t)row0 * DM, DM, (const bf16_t*)(p.ws + OFF_WOUT) + (size_t)col0 * DM, DM, DM, acc, lds, tid);
        const float* gate = mod + (isctx ? 8 : (tm / 9)) * 6144 + 2 * 1024;
#pragma unroll
        for (int m = 0; m < 8; ++m) {
            const int row = row0 + wr * 128 + m * 16 + c;
#pragma unroll
            for (int n = 0; n < 4; ++n) {
                const int col = col0 + wc * 64 + n * 16 + 4 * g;
                const f32x4 gt = *(const f32x4*)(gate + col);
                f32x4* xp = (f32x4*)(X + (size_t)row * DM + col);
                *xp = *xp + gt * acc[m][n];
            }
        }
    }
}

__device__ __forceinline__ void phase_peerq(const DP& p, int l, char* lds, int tid) {
    const int lane = tid & 63, wid = tid >> 6, wr = wid >> 1, wc = wid & 1, g = lane >> 4, c = lane & 15;
    const bf16_t* HX = (const bf16_t*)(p.ws + OFF_HX);
    bf16_t* PQ = (bf16_t*)(p.ws + OFF_PQ);
    TileIter ti;
    if (l == DEPTH_ - 1) ti.init(p, 8, 8, 64); else ti.init(p, 8, 9, 72);
    int tm, tn;
    while (ti.next(tm, tn)) {
        if (l == DEPTH_ - 1) tm = (tm >> 3) * 9 + (tm & 7);
        const int row0 = tm * 256, col0 = tn * 128;
        f32x4 acc[8][4]; zero_acc<8, 4>(acc);
        gemm256<true>(HX + (size_t)row0 * DM, DM, (const bf16_t*)(p.ws + OFF_WPQ) + (size_t)col0 * DM, DM, DM, acc, lds, tid);
#pragma unroll
        for (int m = 0; m < 8; ++m) {
            const int row = row0 + wr * 128 + m * 16 + c;
#pragma unroll
            for (int n = 0; n < 4; ++n) {
                u32x2 w; w.x = pack2(acc[m][n][0], acc[m][n][1]); w.y = pack2(acc[m][n][2], acc[m][n][3]);
                *(u32x2*)(PQ + (size_t)row * DM + col0 + wc * 64 + n * 16 + 4 * g) = w;
            }
        }
    }
}

__device__ __forceinline__ unsigned ord_key(float f) { const unsigned u = __float_as_uint(f); return (u & 0x80000000u) ? ~u : (u | 0x80000000u); }
__device__ __forceinline__ float ord_val(unsigned k) { const unsigned u = (k & 0x80000000u) ? (k & 0x7fffffffu) : ~k; return __uint_as_float(u); }
template <int CTRL> __device__ __forceinline__ unsigned dpp_u(unsigned x) { return (unsigned)__builtin_amdgcn_mov_dpp((int)x, CTRL, 0xf, 0xf, true); }
template <int CTRL> __device__ __forceinline__ float dpp_f(float x) { return __builtin_bit_cast(float, __builtin_amdgcn_mov_dpp(__builtin_bit_cast(int, x), CTRL, 0xf, 0xf, true)); }
__device__ __forceinline__ unsigned row_max_u32(unsigned v) {
    v = max(v, dpp_u<0xB1>(v)); v = max(v, dpp_u<0x4E>(v)); v = max(v, dpp_u<0x141>(v)); v = max(v, dpp_u<0x128>(v));
    return v;
}
__device__ __forceinline__ float row_sum_f32(float v) {
    v += dpp_f<0xB1>(v); v += dpp_f<0x4E>(v); v += dpp_f<0x141>(v); v += dpp_f<0x128>(v);
    return v;
}

template <int NR>
__device__ __forceinline__ void peer_topk(unsigned (&sk)[NR][2][8], int lane, int c, int* pi, float* pg, int pstride) {
    unsigned mine[NR][2];
#pragma unroll
    for (int r = 0; r < NR; ++r) { mine[r][0] = 0u; mine[r][1] = 0u; }
#pragma unroll 1
    for (int rnd = 0; rnd < 16; ++rnd) {
#pragma unroll
        for (int r = 0; r < NR; ++r)
#pragma unroll
            for (int pp = 0; pp < 2; ++pp) {
                unsigned m = sk[r][pp][0];
#pragma unroll
                for (int nf = 1; nf < 8; ++nf) m = max(m, sk[r][pp][nf]);
                m = row_max_u32(m);
#pragma unroll
                for (int nf = 0; nf < 8; ++nf) sk[r][pp][nf] = (sk[r][pp][nf] == m) ? 0u : sk[r][pp][nf];
                if (c == rnd) mine[r][pp] = m;
            }
    }
    float sv[NR][2]; int si[NR][2];
#pragma unroll
    for (int r = 0; r < NR; ++r)
#pragma unroll
        for (int pp = 0; pp < 2; ++pp) { sv[r][pp] = ord_val(mine[r][pp] & ~127u); si[r][pp] = 127 - (int)(mine[r][pp] & 127u); }
    int ptr[NR]; unsigned minec[NR];
#pragma unroll
    for (int r = 0; r < NR; ++r) { ptr[r] = 0; minec[r] = 0u; }
#pragma unroll 1
    for (int rnd = 0; rnd < 16; ++rnd) {
#pragma unroll
        for (int r = 0; r < NR; ++r) {
            const float s0 = __shfl(sv[r][0], (lane & 48) | (ptr[r] & 15));
            const float cv = s0 + sv[r][1];
            unsigned key = (ptr[r] < 16) ? ((ord_key(cv) & ~255u) | (unsigned)(255 - (ptr[r] * 16 + c))) : 0u;
            const unsigned m = row_max_u32(key);
            if (key == m) ptr[r]++;
            if (c == rnd) minec[r] = m;
        }
    }
#pragma unroll
    for (int r = 0; r < NR; ++r) {
        const int flat = 255 - (int)(minec[r] & 255u);
        const int ei = flat >> 4, ej = flat & 15;
        const float tsv = __shfl(sv[r][0], (lane & 48) | ei) + __shfl(sv[r][1], (lane & 48) | ej);
        const int eidx = __shfl(si[r][0], (lane & 48) | ei) * 128 + __shfl(si[r][1], (lane & 48) | ej);
        const float tmax = ord_val(row_max_u32(ord_key(tsv)));
        const float ex = __expf(tsv - tmax);
        pi[r * pstride] = eidx;
        pg[r * pstride] = ex / row_sum_f32(ex);
    }
}

template <bool nostore, bool Q>
__device__ __forceinline__ void peer_item(const DP& p, int l, char* lds, int tid, int row0) {
    typedef float f32x2 __attribute__((ext_vector_type(2)));
    typedef unsigned v6u __attribute__((ext_vector_type(6)));
    typedef float v32f __attribute__((ext_vector_type(32)));
    const int wid = tid >> 6;
    const bf16_t* H2 = (const bf16_t*)(p.ws + OFF_HX);
    const bf16_t* PQ = (const bf16_t*)(p.ws + OFF_PQ);
    const bf16_t* KEYS = (const bf16_t*)(p.ws + KEYS_OFF(l));
    const unsigned char* TUu = (const unsigned char*)(p.ws + OFF_TU);
    const unsigned char* TVv = (const unsigned char*)(p.ws + OFF_TV);
    const float* SUs = (const float*)(p.ws + OFF_SU);
    const float* SVs = (const float*)(p.ws + OFF_SV);
    float* X = (float*)(p.ws + OFF_X);
    const float* mod = (const float*)(p.ws + OFF_MOD) + (size_t)l * 9 * 6144;
    int* park_i = (int*)lds;
    float* park_g = (float*)(lds + 8192);
    {
        int lane = tid & 63;
        asm volatile("" : "+v"(lane));
        const int g = lane >> 4, c = lane & 15;
#pragma unroll 1
        for (int hh = 0; hh < 2; ++hh) {
            const int h = wid * 2 + hh;
            int cl = c, gl = g;
            asm volatile("" : "+v"(cl)); asm volatile("" : "+v"(gl));
            f32x4 sacc[2][8];
#pragma unroll
            for (int pp = 0; pp < 2; ++pp) {
#pragma unroll
                for (int nf = 0; nf < 8; ++nf) sacc[pp][nf] = (f32x4){0.f, 0.f, 0.f, 0.f};
#pragma unroll
                for (int ks = 0; ks < 2; ++ks) {
                    const bf16x8 af = *(const bf16x8*)(PQ + (size_t)(row0 + (Q ? (cl >> 2) : cl)) * DM + (h * 2 + pp) * 64 + ks * 32 + 8 * gl);
#pragma unroll
                    for (int nf = 0; nf < 8; ++nf) {
                        const bf16x8 bfr = *(const bf16x8*)(KEYS + (size_t)((h * 2 + pp) * 128 + nf * 16 + cl) * 64 + ks * 32 + 8 * gl);
                        sacc[pp][nf] = __builtin_amdgcn_mfma_f32_16x16x32_bf16(af, bfr, sacc[pp][nf], 0, 0, 0);
                    }
                }
            }
            {
                constexpr int NR = Q ? 1 : 4;
                unsigned sk[NR][2][8];
#pragma unroll
                for (int r = 0; r < NR; ++r)
#pragma unroll
                    for (int pp = 0; pp < 2; ++pp)
#pragma unroll
                        for (int nf = 0; nf < 8; ++nf) sk[r][pp][nf] = (ord_key(sacc[pp][nf][r]) & ~127u) | (unsigned)(127 - (nf * 16 + c));
                const int pidx = (h * 16 + (Q ? g : 4 * g)) * 16 + c;
                peer_topk<NR>(sk, lane, c, park_i + pidx, park_g + pidx, 16);
            }
        }
        __syncthreads();
        const int ts = Q ? wid : 4 * wid + g;
        const int row = row0 + ts;
        const int bb = row / TU, tt = row - bb * TU;
        const int pb0 = ts * 16;
        constexpr int NG = (Q ? 16 : 64) * 2 / EB;
#define PEER_HD(G_) (Q ? 2 * g + ((G_) >> 3) : ((G_) >> 3))
#define PEER_GC(G_) ((G_) < NG ? (G_) : NG - 1)
#define PEER_IDS(ids_, G_) { _Pragma("unroll") for (int r = 0; r < EB; ++r) \
                ids_[r] = park_i[PEER_HD(PEER_GC(G_)) * 256 + pb0 + (PEER_GC(G_) & 7) * EB + r] & ((FAKEIDX && nostore) ? FAKEIDX : 0xffffff); }
#define PEER_WTS(w_, G_) { _Pragma("unroll") for (int r = 0; r < EB; ++r) w_[r] = park_g[PEER_HD(PEER_GC(G_)) * 256 + pb0 + (PEER_GC(G_) & 7) * EB + r]; }
#define PEER_ROWS(T_, buf_, ids_) { \
            _Pragma("unroll") for (int r = 0; r < EB; ++r) { \
                const unsigned char* rp_ = T_ + (size_t)ids_[r] * TROW + c * 16; \
                _Pragma("unroll") for (int j = 0; j < 3; ++j) buf_[r][j] = *(const u32x4*)(rp_ + j * 256); } }
#define PEER_GQ(buf_, r_, k_) v6u gq; \
            if (k_ == 0) { gq[0] = buf_[r_][0][0]; gq[1] = buf_[r_][0][1]; gq[2] = buf_[r_][0][2]; gq[3] = buf_[r_][0][3]; gq[4] = buf_[r_][1][0]; gq[5] = buf_[r_][1][1]; } \
            else         { gq[0] = buf_[r_][1][2]; gq[1] = buf_[r_][1][3]; gq[2] = buf_[r_][2][0]; gq[3] = buf_[r_][2][1]; gq[4] = buf_[r_][2][2]; gq[5] = buf_[r_][2][3]; }
        {
            f32x2 hf2[32];
#pragma unroll
            for (int j = 0; j < 4; ++j) {
                const u32x4 a = *(const u32x4*)(H2 + (size_t)row * DM + j * 256 + c * 16), bq = *(const u32x4*)(H2 + (size_t)row * DM + j * 256 + c * 16 + 8);
#pragma unroll
                for (int q = 0; q < 4; ++q) { hf2[j * 8 + q] = (f32x2){bflo(a[q]), bfhi(a[q])}; hf2[j * 8 + 4 + q] = (f32x2){bflo(bq[q]), bfhi(bq[q])}; }
            }
            float myw = 0.f;
            u32x4 ua[2][EB][3];
#define PEER_UCOMP(buf_, G_) { \
            f32x2 d2[EB], e2[EB]; \
            _Pragma("unroll") for (int r = 0; r < EB; ++r) { d2[r] = (f32x2){0.f, 0.f}; e2[r] = (f32x2){0.f, 0.f}; } \
            _Pragma("unroll") for (int k = 0; k < 2; ++k) { \
                _Pragma("unroll") for (int r = 0; r < EB; ++r) { \
                    PEER_GQ(buf_, r, k) \
                    asm volatile("" : "+v"(gq[0]) : "v"(d2[(r + EB - 1) % EB])); \
                    v32f dv; \
                    if (NODEC && nostore) { _Pragma("unroll") for (int i = 0; i < 32; ++i) dv[i] = __uint_as_float(gq[i % 6]); } \
                    else dv = __builtin_amdgcn_cvt_scalef32_pk32_f32_fp6(gq, 1.0f); \
                    _Pragma("unroll") for (int i = 0; i < 16; i += 2) { \
                        d2[r] = __builtin_elementwise_fma((f32x2){dv[2 * i], dv[2 * i + 1]}, hf2[k * 16 + i], d2[r]); \
                        e2[r] = __builtin_elementwise_fma((f32x2){dv[2 * i + 2], dv[2 * i + 3]}, hf2[k * 16 + i + 1], e2[r]); } \
                    __builtin_amdgcn_sched_barrier(0); } } \
            _Pragma("unroll") for (int r = 0; r < EB; ++r) { \
                const float dd = row_sum_f32((d2[r].x + d2[r].y) + (e2[r].x + e2[r].y)); \
                if (c == ((G_) & 7) * EB + r) myw = dd; } \
            if (((G_) & 7) == 7) {                            \
                const int pi_ = PEER_HD(G_) * 256 + pb0 + c; \
                const int eidx = park_i[pi_]; \
                const float x_ = myw * SUs[eidx]; \
                const float act = 0.5f * x_ * (1.0f + erff(x_ * 0.70710678118654752f)); \
                park_g[pi_] = park_g[pi_] * act * SVs[eidx]; } }
            int idA[EB], idB[EB];
            PEER_IDS(idA, 0); PEER_ROWS(TUu, ua[0], idA); PEER_IDS(idB, 1);
#pragma unroll 1
            for (int G = 0; G < NG; G += 2) {
                PEER_ROWS(TUu, ua[1], idB); PEER_IDS(idA, G + 2);
                __builtin_amdgcn_sched_barrier(0);
                PEER_UCOMP(ua[0], G);
                __builtin_amdgcn_sched_barrier(0);
                PEER_ROWS(TUu, ua[0], idA);
                PEER_IDS(idB, G + 3);
                __builtin_amdgcn_sched_barrier(0);
                PEER_UCOMP(ua[1], G + 1);
                __builtin_amdgcn_sched_barrier(0);
            }
#undef PEER_UCOMP
        }
        float outv[64];
#pragma unroll
        for (int i = 0; i < 64; ++i) outv[i] = 0.f;
        {
            u32x4 va[2][EB][3];
#define PEER_VCOMP(buf_, wr) { \
            _Pragma("unroll") for (int k = 0; k < 2; ++k) { \
                _Pragma("unroll") for (int r = 0; r < EB; ++r) { \
                    PEER_GQ(buf_, r, k) \
                    asm volatile("" : "+v"(gq[0]) : "v"(outv[k * 32 + 31])); \
                    v32f dv; \
                    if (NODEC && nostore) { _Pragma("unroll") for (int i = 0; i < 32; ++i) dv[i] = __uint_as_float(gq[i % 6]); } \
                    else dv = __builtin_amdgcn_cvt_scalef32_pk32_f32_fp6(gq, 1.0f); \
                    _Pragma("unroll") for (int i = 0; i < 32; ++i) outv[k * 32 + i] += wr[r] * dv[i]; \
                    __builtin_amdgcn_sched_barrier(0); } } }
            int idA[EB], idB[EB]; float w0[EB], w1[EB];
            PEER_IDS(idA, 0); PEER_ROWS(TVv, va[0], idA); PEER_IDS(idB, 1); PEER_WTS(w0, 0);
#pragma unroll 1
            for (int G = 0; G < NG; G += 2) {
                PEER_ROWS(TVv, va[1], idB); PEER_IDS(idA, G + 2); PEER_WTS(w1, G + 1);
                __builtin_amdgcn_sched_barrier(0);
                PEER_VCOMP(va[0], w0);
                __builtin_amdgcn_sched_barrier(0);
                if (G + 2 < NG) PEER_ROWS(TVv, va[0], idA);
                PEER_IDS(idB, G + 3); PEER_WTS(w0, G + 2);
                __builtin_amdgcn_sched_barrier(0);
                PEER_VCOMP(va[1], w1);
                __builtin_amdgcn_sched_barrier(0);
            }
#undef PEER_VCOMP
        }
#undef PEER_ROWS
#undef PEER_IDS
#undef PEER_WTS
#undef PEER_GC
#undef PEER_GQ
#undef PEER_HD
        if (Q) {
#pragma unroll
            for (int i = 0; i < 64; ++i) { outv[i] += __shfl_xor(outv[i], 16); outv[i] += __shfl_xor(outv[i], 32); }
        }
        if (nostore) {
#pragma unroll
            for (int i = 0; i < 64; ++i) asm volatile("" :: "v"(outv[i]));
        } else {
            const float* gate = mod + (tt >= SEQ ? 8 : bb) * 6144 + 5 * 1024;
            int rowl = row;
            asm volatile("" : "+v"(rowl));
            float ss = 0.f;
#pragma unroll
            for (int j = 0; j < 4; ++j) {
#pragma unroll
                for (int q = 0; q < 4; ++q) {
                    const int col = j * 256 + c * 16 + 4 * q;
                    const f32x4 g0 = *(const f32x4*)(gate + col);
                    f32x4* xp = (f32x4*)(X + (size_t)rowl * DM + col);
                    f32x4 x0 = *xp;
#pragma unroll
                    for (int i = 0; i < 4; ++i) { x0[i] += g0[i] * outv[j * 16 + 4 * q + i]; outv[j * 16 + 4 * q + i] = x0[i]; ss += x0[i] * x0[i]; }
                    if (l != DEPTH_ - 1 && (!Q || j == g)) *xp = x0;
                }
                __builtin_amdgcn_sched_barrier(0);
            }
            if (l != DEPTH_ - 1) {
                const float rstd = rsqrtf(row_sum_f32(ss) * (1.0f / 1024.0f) + 1e-6f);
                const float* gvec = p.in[I_N1G] + (l + 1) * DM;
                const float* mrow = mod + 9 * 6144 + (tt >= SEQ ? 8 : bb) * 6144;
                bf16_t* hrow = (bf16_t*)(p.ws + OFF_HX) + (size_t)row * DM;
#pragma unroll
                for (int j = 0; j < 4; ++j) {
                    if (!Q || j == g) {
#pragma unroll
                        for (int q = 0; q < 4; ++q) {
                            const int col = j * 256 + c * 16 + 4 * q;
                            const f32x4 g4 = *(const f32x4*)(gvec + col);
                            const f32x4 sh = *(const f32x4*)(mrow + col);
                            const f32x4 sc = *(const f32x4*)(mrow + 1024 + col);
                            float y[4];
#pragma unroll
                            for (int i = 0; i < 4; ++i) y[i] = outv[j * 16 + 4 * q + i] * rstd * g4[i] * (1.0f + sc[i]) + sh[i];
                            u32x2 w; w.x = pack2(y[0], y[1]); w.y = pack2(y[2], y[3]);
                            *(u32x2*)(hrow + col) = w;
                        }
                    }
                    __builtin_amdgcn_sched_barrier(0);
                }
            }
            if (l == DEPTH_ - 1) {
                const float rstd = rsqrtf(row_sum_f32(ss) * (1.0f / 1024.0f) + 1e-6f);
                const float* fg = p.in[I_FG];
                float* orow = p.out + (size_t)(bb * SEQ + tt) * DM;
#pragma unroll
                for (int j = 0; j < 4; ++j) {
                    if (!Q || j == g) {
#pragma unroll
                        for (int q = 0; q < 4; ++q) {
                            const int col = j * 256 + c * 16 + 4 * q;
                            const f32x4 f4 = *(const f32x4*)(fg + col);
                            f32x4 o4;
#pragma unroll
                            for (int i = 0; i < 4; ++i) o4[i] = outv[j * 16 + 4 * q + i] * rstd * f4[i];
                            *(f32x4*)(orow + col) = o4;
                        }
                    }
                    __builtin_amdgcn_sched_barrier(0);
                }
            }
        }
        __syncthreads();
    }
}

template <bool nostore>
__device__ __forceinline__ void phase_peer(const DP& p, int l, char* lds, int tid) {
    const int nbi = (l == 0) ? RR / 16 : NB * SEQ / 16;
    const int nfull = (nbi / p.nblk) * p.nblk;
    for (int bi = p.bid; bi < nfull; bi += p.nblk) {
        int row0;
        if (l == 0) row0 = bi * 16; else { const int b = bi / (SEQ / 16); row0 = b * TU + (bi % (SEQ / 16)) * 16; }
        peer_item<nostore, false>(p, l, lds, tid, row0);
    }
    for (int qi = p.bid; qi < (nbi - nfull) * 4; qi += p.nblk) {
        const int bi = nfull + (qi >> 2);
        int row0;
        if (l == 0) row0 = bi * 16; else { const int b = bi / (SEQ / 16); row0 = b * TU + (bi % (SEQ / 16)) * 16; }
        peer_item<nostore, true>(p, l, lds, tid, row0 + (qi & 3) * 4);
    }
}

__device__ __forceinline__ void phase_final(const DP& p, int tid) {
    const int lane = tid & 63;
    const int gw = p.bid * 4 + (tid >> 6), nw = p.nblk * 4;
    const float* X = (const float*)(p.ws + OFF_X);
    const float* fg = p.in[I_FG];
    for (int r = gw; r < NB * SEQ; r += nw) {
        const int b = r / SEQ, t = r - b * SEQ;
        const float* src = X + (size_t)(b * TU + t) * DM;
        f32x4 v[4]; float ss = 0.f;
#pragma unroll
        for (int j = 0; j < 4; ++j) { v[j] = *(const f32x4*)(src + j * 256 + lane * 4); ss += v[j][0] * v[j][0] + v[j][1] * v[j][1] + v[j][2] * v[j][2] + v[j][3] * v[j][3]; }
        ss = wave_sum(ss);
        const float rstd = rsqrtf(ss * (1.0f / 1024.0f) + 1e-6f);
#pragma unroll
        for (int j = 0; j < 4; ++j) {
            const f32x4 g4 = *(const f32x4*)(fg + j * 256 + lane * 4);
            *(f32x4*)(p.out + (size_t)r * DM + j * 256 + lane * 4) = v[j] * rstd * g4;
        }
    }
}

#define NPHASE 23
#ifndef DUP_S
#define DUP_S -1
#endif
#ifndef DUP_SUB
#define DUP_SUB 0
#endif
#ifdef XCC_REMAP
#define BID_SRC __builtin_amdgcn_readfirstlane(*(volatile int*)(lds + LDS_MISC + 976))
#else
#define BID_SRC blockIdx.x
#endif
#define LAUNDER() DP p; *(Params*)&p = p_in; int tid = threadIdx.x; { int bid_ = BID_SRC, nblk_ = gridDim.x; \
    asm volatile("" : "+v"(tid)); asm volatile("" : "+s"(p.ws)); asm volatile("" : "+s"(bid_)); asm volatile("" : "+s"(nblk_)); p.bid = bid_; p.nblk = nblk_; }
#define GBAR() { gchar* wsb_ = p_in.ws; asm volatile("" : "+s"(wsb_)); xcd_barrier((unsigned*)(wsb_ + OFF_BAR), st); }
#define REP(s_) _Pragma("unroll 1") for (int r_ = (DUP_S == (s_) ? 0 : 1); r_ < 2; ++r_)

#ifndef ONLY
#define ONLY -1
#endif
#ifndef FAKE
#define FAKE 0
#endif
#define ON(k) (ONLY < 0 || ONLY == (k))
#define RUN_LAYER(L) \
    if (L == 0) { if (ON(0)) { LAUNDER(); REP(0) { norm_pass(p, L, 0, tid); conv_weights(p, L, lds, tid); } } GBAR(); }     \
    if (ON(1)) { LAUNDER(); REP(1) phase_inproj(p, L, lds, tid, r_ == 0 ? FAKE : 0); } GBAR(); \
    if (ON(2)) { LAUNDER(); REP(2) phase_mla(p, L, lds, tid); } GBAR(); \
    if (ON(3)) { LAUNDER(); REP(3) phase_mixers(p, L, lds, tid, r_ == 0 ? DUP_SUB : 15); } GBAR(); \
    if (ON(4)) { LAUNDER(); REP(4) phase_combine(p, L, tid); } GBAR(); \
    if (ON(5)) { LAUNDER(); REP(5) phase_merge(p, L, lds, tid); phase_convq(p, L, lds, tid); } GBAR(); \
    if (ON(6)) { LAUNDER(); phase_wout(p, L, lds, tid); } GBAR(); \
    if (ON(7)) { LAUNDER(); REP(7) { norm_pass(p, L, 1, tid); } } GBAR(); \
    if (ON(8)) { LAUNDER(); REP(8) phase_peerq(p, L, lds, tid); if (L + 1 < DEPTH_ && CONVW_IN8) conv_weights(p, L + 1, lds, tid, 1); } GBAR();     \
    if (ON(9)) { LAUNDER(); if (DUP_S == 9) phase_peer<true>(p, L, lds, tid); phase_peer<false>(p, L, lds, tid); if (L + 1 < DEPTH_) { if (!CONVW_IN8) conv_weights(p, L + 1, lds, tid, 1); conv_weights(p, L + 1, lds, tid, 2); } } if (L != DEPTH_ - 1) GBAR();

__global__ void __launch_bounds__(NTHREADS, 2) fwd_kernel(Params p_in) {
    __shared__ __attribute__((aligned(16))) char lds[LDS_BYTES];
    volatile unsigned* st = (volatile unsigned*)(lds + LDS_MISC + 1008);
    if (threadIdx.x == 0) {
        st[0] = 0u; st[1] = 0u;
#ifdef XCC_REMAP
        const unsigned xcc = xb_xcc_id() & 7u;
        const unsigned rank = xb_add((unsigned*)(p_in.ws + OFF_BAR) + 3712 + 16 * xcc, 1u);
        *(volatile int*)(lds + LDS_MISC + 976) = (int)(rank * 8u + xcc);
#endif
    }
    __syncthreads();
    xcd_barrier_post((unsigned*)(p_in.ws + OFF_BAR));
    { LAUNDER(); phase_p0(p, lds, tid); } GBAR();
    { LAUNDER(); phase_p0b(p, tid); } GBAR();
    RUN_LAYER(0)
    RUN_LAYER(1)
}

extern "C" void kernel_launch(void* const* d_in, const int* in_sizes, int n_in, void* d_out, int out_size, void* d_ws, size_t ws_size, hipStream_t stream) {
    static int grid_blocks = 0;
    if (!grid_blocks) {
        int dev = 0, cus = 0, per_cu = 0;
        hipGetDevice(&dev);
        hipDeviceGetAttribute(&cus, hipDeviceAttributeMultiprocessorCount, dev);
        hipOccupancyMaxActiveBlocksPerMultiprocessor(&per_cu, fwd_kernel, NTHREADS, 0);
        if (per_cu > 2) per_cu = 2;
        if (per_cu < 1) per_cu = 1;
        grid_blocks = cus * per_cu;
        if (ws_size < OFF_TOP) fprintf(stderr, "workspace too small: %zu < %zu\n", ws_size, (size_t)OFF_TOP);
    }
    Params p{};
    for (int i = 0; i < 28; ++i) p.in[i] = (const float*)d_in[i];
    p.out = (float*)d_out;
    p.ws = (gchar*)d_ws;
#if MEGA
    hipMemsetAsync(d_ws, 0, 16384, stream);
    void* args[] = {&p};
    hipError_t e = hipLaunchCooperativeKernel((void*)fwd_kernel, dim3(grid_blocks), dim3(NTHREADS), args, 0, stream);
    if (e != hipSuccess) fprintf(stderr, "cooperative launch failed: %s (grid %d)\n", hipGetErrorString(e), grid_blocks);
#endif
}
```

```cpp
#include <hip/hip_runtime.h>
#include <stdint.h>
#include <stdio.h>

#ifndef MEGA
#define MEGA 1
#endif

typedef unsigned short bf16_t;
typedef short bf16x8 __attribute__((ext_vector_type(8)));
typedef float f32x4 __attribute__((ext_vector_type(4)));
typedef unsigned u32x4 __attribute__((ext_vector_type(4)));
typedef unsigned u32x2 __attribute__((ext_vector_type(2)));
typedef __bf16 bf16x2_t __attribute__((ext_vector_type(2)));

#define NB 8
#define SEQ 2048
#define CTXL 256
#define TU 2304
#define RR (NB * TU)
#define DM 1024
#define PW 3072
#define NTHREADS 256
#define LOG2E 1.4426950408889634f

#define PC_AQ 0
#define PC_AK1 512
#define PC_AK2 768
#define PC_CQ 1024
#define PC_CKV 1280
#define PC_HOH 1408
#define PC_HG 1920
#define PC_DQ 2432
#define PC_DK 2944

#define OFF_BAR   ((size_t)0)
#define OFF_MODP  ((size_t)16384)
#define OFF_MOD   (OFF_MODP + (size_t)2 * 8 * 9 * 6144 * 4)
#define OFF_ROPE  (OFF_MOD + (size_t)2 * 9 * 6144 * 4)
#define OFF_LB    (OFF_ROPE + (size_t)2048 * 32 * 8)
#define OFF_LAM   (OFF_LB + (size_t)2 * 2 * 512 * 4)
#define OFF_X     (OFF_LAM + (size_t)256)
#define OFF_HX    (OFF_X + (size_t)RR * DM * 4)
#define OFF_WIN   (OFF_HX + (size_t)RR * DM * 2)
#define OFF_WV    (OFF_WIN + (size_t)2688 * 1024 * 2)
#define OFF_WG    (OFF_WV + (size_t)2688 * 1024 * 2)
#define OFF_WUQ   (OFF_WG + (size_t)4096 * 1024 * 2)
#define OFF_WUK   (OFF_WUQ + (size_t)768 * 256 * 2)
#define OFF_WUV   (OFF_WUK + (size_t)512 * 128 * 2)
#define OFF_WBR   (OFF_WUV + (size_t)512 * 128 * 2)
#define OFF_WOUT  (OFF_WBR + (size_t)4 * 1024 * 512 * 2)
#define OFF_WPQ   (OFF_WOUT + (size_t)1024 * 1024 * 2)
#define OFF_KEYS  (OFF_WPQ + (size_t)1024 * 1024 * 2)
#define OFF_P     (OFF_KEYS + (size_t)8 * 2 * 128 * 64 * 2)
#define OFF_QB    (OFF_P + (size_t)RR * PW * 2)
#define OFF_KB    (OFF_QB + (size_t)RR * 768 * 2)
#define OFF_VTB   (OFF_KB + (size_t)RR * 768 * 2)
#define OFF_VTA   (OFF_VTB + (size_t)NB * 4 * 128 * TU * 2)
#define OFF_VTD   (OFF_VTA + (size_t)NB * 4 * 128 * TU * 2)
#define OFF_OA12  (OFF_VTD + (size_t)NB * 2 * 64 * TU * 2)
#define OFF_OB    (OFF_OA12 + (size_t)RR * 1024 * 2)
#define OFF_OHB   (OFF_OB + (size_t)RR * 512 * 2)
#define OFF_HT    (OFF_OHB + (size_t)RR * 512 * 2)
#define OFF_END   (OFF_HT + (size_t)NB * 4 * 4 * 128 * TU * 2)
#define OFF_Y     OFF_OA12
#define OFF_PQ    OFF_QB
#define OFF_TU    OFF_END
#define OFF_TV    (OFF_END + (size_t)16384 * 768)
#define OFF_SU    (OFF_END + (size_t)2 * 16384 * 768)
#define OFF_SV    (OFF_SU + 65536)
#define OFF_KEYS2 (OFF_SV + 65536)
#define KEYS_OFF(l) (((l) & 1) ? OFF_KEYS2 : OFF_KEYS)
#define OFF_TOP   (OFF_KEYS2 + (size_t)8 * 2 * 128 * 64 * 2)

typedef __attribute__((address_space(1))) char gchar;
struct Params {
    const float* in[28];
    float* out;
    gchar* ws;
};
struct DP : Params { int bid; int nblk; };

enum { I_X = 0, I_C, I_CTX, I_CCTX, I_WMOD, I_BMOD, I_N1G, I_N2G, I_WIN, I_LQ1, I_LK1, I_LQ2, I_LK2, I_DNG, I_QNG, I_KVNG, I_WUQ, I_WUKV,
       I_HLB, I_HNG, I_SINK, I_WBR, I_WOUT, I_PWQ, I_PKEYS, I_PU, I_PV, I_FG };

__device__ __forceinline__ unsigned f2bf(float f) { return (unsigned)__builtin_bit_cast(unsigned short, (__bf16)f); }
__device__ __forceinline__ float bflo(unsigned w) { return __uint_as_float(w << 16); }
__device__ __forceinline__ float bfhi(unsigned w) { return __uint_as_float(w & 0xffff0000u); }
__device__ __forceinline__ unsigned pack2(float a, float b) { bf16x2_t v = {(__bf16)a, (__bf16)b}; return __builtin_bit_cast(unsigned, v); }
__device__ __forceinline__ float wave_sum(float v) {
#pragma unroll
    for (int o = 32; o >= 1; o >>= 1) v += __shfl_xor(v, o);
    return v;
}
typedef unsigned v2u_t __attribute__((ext_vector_type(2)));
__device__ __forceinline__ float fmax_raw(float a, float b) { float r; asm("v_max_f32 %0, %1, %2" : "=v"(r) : "v"(a), "v"(b)); return r; }
__device__ __forceinline__ float rows_max(float v) {
    const v2u_t a = __builtin_amdgcn_permlane16_swap(__float_as_uint(v), __float_as_uint(v), false, false);
    v = fmax_raw(__uint_as_float(a.x), __uint_as_float(a.y));
    const v2u_t b = __builtin_amdgcn_permlane32_swap(__float_as_uint(v), __float_as_uint(v), false, false);
    return fmax_raw(__uint_as_float(b.x), __uint_as_float(b.y));
}
__device__ __forceinline__ float rows_sum(float v) {
    const v2u_t a = __builtin_amdgcn_permlane16_swap(__float_as_uint(v), __float_as_uint(v), false, false);
    v = __uint_as_float(a.x) + __uint_as_float(a.y);
    const v2u_t b = __builtin_amdgcn_permlane32_swap(__float_as_uint(v), __float_as_uint(v), false, false);
    return __uint_as_float(b.x) + __uint_as_float(b.y);
}
__device__ __forceinline__ float sigmoidf_(float x) { return 1.0f / (1.0f + __expf(-x)); }
__device__ __forceinline__ float siluf_(float x) { return x / (1.0f + __expf(-x)); }
__device__ __forceinline__ float dot2bf(unsigned a, unsigned b, float acc) {
    return __builtin_amdgcn_fdot2_f32_bf16(__builtin_bit_cast(bf16x2_t, a), __builtin_bit_cast(bf16x2_t, b), acc, false);
}

#define XB_TMO      128
#define XB_XCNT(j)  (256  + 64 * (j))
#define XB_XSUB(j)  (1280 + 64 * (j))
#define XB_XGEN(j)  (2304 + 64 * (j))
#define XB_TOP      3328
#define XB_TOPGEN   3392
#define XCD_BAR_WORDS 3456
#define XB_SPIN_CAP (1u << 22)
#define LAS __attribute__((address_space(3)))

__device__ __forceinline__ unsigned xb_ld(unsigned* p)              { return __hip_atomic_load(p, __ATOMIC_RELAXED, __HIP_MEMORY_SCOPE_AGENT); }
__device__ __forceinline__ unsigned xb_add(unsigned* p, unsigned v) { return __hip_atomic_fetch_add(p, v, __ATOMIC_RELAXED, __HIP_MEMORY_SCOPE_AGENT); }
__device__ __forceinline__ unsigned xb_xcc_id() { return (unsigned)__builtin_amdgcn_s_getreg((3 << 11) | 20) & 0xFu; }
#define XB_SPIN(cond, bar) do { unsigned _sp = 0; while (cond) { __builtin_amdgcn_s_sleep(1); \
    if ((++_sp & 255u) == 0u) { if (xb_ld(&(bar)[XB_TMO])) break; if (_sp > XB_SPIN_CAP) { atomicAdd(&(bar)[XB_TMO], 1u); break; } } } } while (0)

__device__ __forceinline__ void xcd_barrier_post(unsigned* bar) {
    if (threadIdx.x == 0) (void)xb_add(&bar[XB_XCNT(xb_xcc_id())], 1u);
}
__device__ __forceinline__ void xcd_barrier_complete(unsigned* bar, unsigned x, unsigned& nloc, unsigned& nx) {
    const unsigned G = gridDim.x;
    unsigned sum, cnt, mine, sp = 0u;
    for (;;) {
        sum = 0u; cnt = 0u; mine = 0u;
#pragma unroll 1
        for (unsigned j = 0; j < 16; ++j) { const unsigned c = xb_ld(&bar[XB_XCNT(j)]); sum += c; cnt += (c > 0u) ? 1u : 0u; mine = (j == x) ? c : mine; }
        if (sum == G) break;
        __builtin_amdgcn_s_sleep(1);
        if ((++sp & 255u) == 0u) { if (xb_ld(&bar[XB_TMO])) break; if (sp > XB_SPIN_CAP) { atomicAdd(&bar[XB_TMO], 1u); break; } }
    }
    nloc = mine > 0u ? mine : 1u; nx = cnt > 0u ? cnt : 1u;
}
__device__ __forceinline__ void xcd_barrier(unsigned* bar, volatile unsigned* st) {
    asm volatile("s_waitcnt vmcnt(0)" ::: "memory");
    __syncthreads();
    if (threadIdx.x == 0) {
        const unsigned x = xb_xcc_id();
        __builtin_amdgcn_s_waitcnt(0);
        unsigned nloc = st[0], nx = st[1];
        if (nloc == 0u) { xcd_barrier_complete(bar, x, nloc, nx); st[0] = nloc; st[1] = nx; }
        const unsigned old = xb_add(&bar[XB_XSUB(x)], 1u);
        const unsigned gen = old / nloc;
        if (old + 1u == (gen + 1u) * nloc) {
            __builtin_amdgcn_fence(__ATOMIC_RELEASE, "agent");
            asm volatile("s_waitcnt vmcnt(0)" ::: "memory");
            const unsigned og = xb_add(&bar[XB_TOP], 1u);
            const unsigned tg = og / nx;
            if (og + 1u == (tg + 1u) * nx) xb_add(&bar[XB_TOPGEN], 1u);
            else XB_SPIN(xb_ld(&bar[XB_TOPGEN]) == tg, bar);
            __builtin_amdgcn_fence(__ATOMIC_ACQUIRE, "agent");
            xb_add(&bar[XB_XGEN(x)], 1u);
            asm volatile("s_waitcnt vmcnt(0)" ::: "memory");
        } else {
            XB_SPIN(xb_ld(&bar[XB_XGEN(x)]) == gen, bar);
            __builtin_amdgcn_fence(__ATOMIC_ACQUIRE, "agent");
            asm volatile("s_waitcnt vmcnt(0)" ::: "memory");
        }
    }
    __syncthreads();
}

#define LDS_BYTES 74752
#define LDS_MISC  73728

__device__ __forceinline__ void phase_p0(const DP& p, char* lds, int tid) {
    float* modp = (float*)(p.ws + OFF_MODP);
    float* sl = (float*)lds;
    const int nitems = 2 * 8 * 24;
    for (int it = p.bid; it < nitems; it += p.nblk) {
        const int l = it / 192, rem = it % 192, ks = rem / 24, cb = rem % 24;
        const int k0 = ks * 128;
        __syncthreads();
        for (int e = tid; e < 9 * 128; e += NTHREADS) {
            const int r = e >> 7, k = e & 127;
            const float cv = (r < 8) ? p.in[I_C][r * DM + k0 + k] : p.in[I_CCTX][k0 + k];
            sl[e] = siluf_(cv);
        }
        __syncthreads();
        const int col = cb * 256 + tid;
        const float* w = p.in[I_WMOD] + (size_t)l * DM * 6144 + (size_t)k0 * 6144 + col;
        float acc[9];
#pragma unroll
        for (int r = 0; r < 9; ++r) acc[r] = 0.f;
        for (int k = 0; k < 128; ++k) {
            const float wv = w[(size_t)k * 6144];
#pragma unroll
            for (int r = 0; r < 9; ++r) acc[r] += sl[r * 128 + k] * wv;
        }
#pragma unroll
        for (int r = 0; r < 9; ++r) modp[((size_t)(l * 8 + ks) * 9 + r) * 6144 + col] = acc[r];
    }
    float2* rope = (float2*)(p.ws + OFF_ROPE);
    for (int e = p.bid * NTHREADS + tid; e < 2048 * 32; e += p.nblk * NTHREADS) {
        const int t = e >> 5, a = (e >> 4) & 1, i = e & 15;
        const float freq = exp2f(-(float)i * (13.287712379549449f / 16.0f));
        const float pos = (float)(a == 0 ? (t >> 6) : (t & 63));
        const float ang = pos * freq;
        rope[e] = make_float2(cosf(ang), sinf(ang));
    }
    float* lb = (float*)(p.ws + OFF_LB);
    for (int e = p.bid * NTHREADS + tid; e < 2 * 512; e += p.nblk * NTHREADS) {
        const int d = e >> 9, c = e & 511;
        const float h0 = p.in[I_HLB][(d * 2 + 0) * 512 + c], h1 = p.in[I_HLB][(d * 2 + 1) * 512 + c];
        const float mx = fmaxf(h0, h1);
        const float e0 = expf(h0 - mx), e1 = expf(h1 - mx);
        const float p1 = e1 / (e0 + e1);
        lb[(d * 2 + 0) * 512 + c] = 0.f;
        lb[(d * 2 + 1) * 512 + c] = p1;
    }
    if (p.bid == 0 && tid < 2) {
        const int l = tid;
        float s1 = 0.f, s2 = 0.f;
        for (int i = 0; i < 64; ++i) {
            s1 += p.in[I_LQ1][l * 64 + i] * p.in[I_LK1][l * 64 + i];
            s2 += p.in[I_LQ2][l * 64 + i] * p.in[I_LK2][l * 64 + i];
        }
        const float lam_init = 0.8f - 0.6f * expf(-0.3f * (float)l);
        float* lam = (float*)(p.ws + OFF_LAM);
        lam[l * 2 + 0] = expf(s1) - expf(s2) + lam_init;
        lam[l * 2 + 1] = lam_init;
    }
}

__device__ __forceinline__ void phase_p0b(const DP& p, int tid) {
    const float* modp = (const float*)(p.ws + OFF_MODP);
    float* mod = (float*)(p.ws + OFF_MOD);
    for (int e = p.bid * NTHREADS + tid; e < 2 * 9 * 6144; e += p.nblk * NTHREADS) {
        const int l = e / (9 * 6144), rem = e % (9 * 6144), r = rem / 6144, col = rem % 6144;
        float s = p.in[I_BMOD][l * 6144 + col];
#pragma unroll
        for (int ks = 0; ks < 8; ++ks) s += modp[((size_t)(l * 8 + ks) * 9 + r) * 6144 + col];
        mod[e] = s;
    }
}

__device__ __forceinline__ void norm_pass(const DP& p, int l, int which, int tid) {
    const int lane = tid & 63;
    const int gw = p.bid * 4 + (tid >> 6), nw = p.nblk * 4;
    const float* gvec = p.in[which ? I_N2G : I_N1G] + l * DM;
    const float* mod = (const float*)(p.ws + OFF_MOD) + (size_t)l * 9 * 6144;
    float* X = (float*)(p.ws + OFF_X);
    bf16_t* HX = (bf16_t*)(p.ws + OFF_HX);
    const int seg_sh = which ? 3 : 0, seg_sc = which ? 4 : 1;
    for (int row = gw; row < RR; row += nw) {
        const int b = row / TU, t = row - b * TU;
        const bool isctx = t >= SEQ;
        if (which == 1 && l == 1 && isctx) continue;
        const float* src;
        if (which == 0 && l == 0) src = isctx ? p.in[I_CTX] + (size_t)(b * CTXL + t - SEQ) * DM : p.in[I_X] + (size_t)(b * SEQ + t) * DM;
        else src = X + (size_t)row * DM;
        const float* mrow = mod + (isctx ? 8 : b) * 6144;
        f32x4 v[4]; float ss = 0.f;
#pragma unroll
        for (int j = 0; j < 4; ++j) {
            v[j] = *(const f32x4*)(src + j * 256 + lane * 4);
            ss += v[j][0] * v[j][0] + v[j][1] * v[j][1] + v[j][2] * v[j][2] + v[j][3] * v[j][3];
        }
        ss = wave_sum(ss);
        const float rstd = rsqrtf(ss * (1.0f / 1024.0f) + 1e-6f);
#pragma unroll
        for (int j = 0; j < 4; ++j) {
            const int col = j * 256 + lane * 4;
            if (which == 0 && l == 0) *(f32x4*)(X + (size_t)row * DM + col) = v[j];
            const f32x4 g4 = *(const f32x4*)(gvec + col);
            const f32x4 sh = *(const f32x4*)(mrow + seg_sh * 1024 + col);
            const f32x4 sc = *(const f32x4*)(mrow + seg_sc * 1024 + col);
            float y[4];
#pragma unroll
            for (int i = 0; i < 4; ++i) y[i] = v[j][i] * rstd * g4[i] * (1.0f + sc[i]) + sh[i];
            u32x2 w; w.x = pack2(y[0], y[1]); w.y = pack2(y[2], y[3]);
            *(u32x2*)(HX + (size_t)row * DM + col) = w;
        }
    }
}

__device__ __forceinline__ void conv_tr64(const float* src, int ld, int srccol, int k0, int K, bf16_t* dst, const float* fold, float* lt, int tid, bool perm = false) {
    __syncthreads();
#pragma unroll
    for (int i = 0; i < 4; ++i) {
        const int r = (tid >> 4) + 16 * i, c4 = tid & 15;
        f32x4 val = {0.f, 0.f, 0.f, 0.f};
        if (srccol >= 0) val = *(const f32x4*)(src + (size_t)(k0 + r) * ld + srccol + c4 * 4);
        if (fold) { const float f = fold[k0 + r]; val = val * f; }
        lt[r * 65 + c4 * 4 + 0] = val[0]; lt[r * 65 + c4 * 4 + 1] = val[1]; lt[r * 65 + c4 * 4 + 2] = val[2]; lt[r * 65 + c4 * 4 + 3] = val[3];
    }
    __syncthreads();
    const int n = tid >> 2, seg = tid & 3;
    unsigned w[8];
#pragma unroll
    for (int i = 0; i < 8; ++i) w[i] = pack2(lt[(seg * 16 + 2 * i) * 65 + n], lt[(seg * 16 + 2 * i + 1) * 65 + n]);
    const int nrow = perm ? (((n >> 4) & 1) * 32 + ((n >> 2) & 1) * 16 + (n >> 5) * 8 + ((n >> 3) & 1) * 4 + (n & 3)) : n;
    bf16_t* d = dst + (size_t)nrow * K + k0 + seg * 16;
    u32x4 a = {w[0], w[1], w[2], w[3]}, bq = {w[4], w[5], w[6], w[7]};
    *(u32x4*)d = a; *(u32x4*)(d + 8) = bq;
}

__device__ __forceinline__ int win_srccol(int chunk) {
    if (chunk < 8) return (chunk & 1) * 256 + (chunk >> 1) * 64;
    if (chunk < 16) return 512 + (chunk - 8) * 64;
    if (chunk < 22) return 1536 + (chunk - 16) * 64;
    if (chunk < 30) return 4032 + (chunk - 22) * 64;
    if (chunk < 40) return 4544 + (chunk - 30) * 64;
    if (chunk == 40) return 1920;
    return -1;
}
__device__ __forceinline__ int wt_srccol(int chunk) {
    if (chunk < 8) return 1024 + chunk * 64;
    if (chunk < 10) return 5184 + (chunk - 8) * 64;
    return 1984 + (chunk - 10) * 64;
}

__device__ __forceinline__ void conv_weights(const DP& p, int l, char* lds, int tid, int part = 0) {
    float* lt = (float*)lds;
    const float* w_in = p.in[I_WIN] + (size_t)l * DM * 9408;
    const int n_main = 42 * 16, n_v = 42 * 16, n_g = 64 * 16, n_uq = 12 * 4, n_uk = 8 * 2, n_uv = 8 * 2, n_br = 4 * 16 * 8, n_out = 256, n_pq = 256, n_keys = 64;
    const int total = n_main + n_v + n_g + n_uq + n_uk + n_uv + n_br + n_out + n_pq + n_keys;
    const int lo = part == 2 ? total - n_pq - n_keys : 0, hi = part == 1 ? total - n_pq - n_keys : total;
    unsigned* qctr = (unsigned*)(p.ws + OFF_BAR) + 3520 + 64 * (l & 1) + 48;
    volatile int* slot = (volatile int*)(lds + 73728 + 992);
    asm volatile("s_waitcnt vmcnt(0)" ::: "memory");
    __syncthreads();
    for (int it0 = lo + p.bid; ; it0 += p.nblk) {
        if (part == 1) {
            __syncthreads();
            if (tid == 0) *slot = (int)atomicAdd(qctr, 1u);
            __syncthreads();
            it0 = lo + *slot;
        }
        if (it0 >= hi) break;
        int it = it0;
        if (it < n_main) { const int ch = it >> 4, kb = it & 15;
            conv_tr64(w_in, 9408, win_srccol(ch), kb * 64, 1024, (bf16_t*)(p.ws + OFF_WIN) + (size_t)ch * 64 * 1024, nullptr, lt, tid, true); continue; }
        it -= n_main;
        if (it < n_v) { const int ch = it >> 4, kb = it & 15;
            conv_tr64(w_in, 9408, wt_srccol(ch), kb * 64, 1024, (bf16_t*)(p.ws + OFF_WV) + (size_t)ch * 64 * 1024, nullptr, lt, tid); continue; }
        it -= n_v;
        if (it < n_g) { const int ch = it >> 4, kb = it & 15;
            conv_tr64(w_in, 9408, 5312 + ch * 64, kb * 64, 1024, (bf16_t*)(p.ws + OFF_WG) + (size_t)ch * 64 * 1024, nullptr, lt, tid); continue; }
        it -= n_g;
        if (it < n_uq) { const int ch = it >> 2, kb = it & 3;
            conv_tr64(p.in[I_WUQ] + (size_t)l * 256 * 768, 768, ch * 64, kb * 64, 256, (bf16_t*)(p.ws + OFF_WUQ) + (size_t)ch * 64 * 256, p.in[I_QNG] + l * 256, lt, tid); continue; }
        it -= n_uq;
        if (it < n_uk) { const int ch = it >> 1, kb = it & 1;
            conv_tr64(p.in[I_WUKV] + (size_t)l * 128 * 1024, 1024, (ch >> 1) * 256 + (ch & 1) * 64, kb * 64, 128, (bf16_t*)(p.ws + OFF_WUK) + (size_t)ch * 64 * 128, p.in[I_KVNG] + l * 128, lt, tid); continue; }
        it -= n_uk;
        if (it < n_uv) { const int ch = it >> 1, kb = it & 1;
            conv_tr64(p.in[I_WUKV] + (size_t)l * 128 * 1024, 1024, (ch >> 1) * 256 + 128 + (ch & 1) * 64, kb * 64, 128, (bf16_t*)(p.ws + OFF_WUV) + (size_t)ch * 64 * 128, p.in[I_KVNG] + l * 128, lt, tid); continue; }
        it -= n_uv;
        if (it < n_br) { const int j = it >> 7, r2 = it & 127, ch = r2 >> 3, kb = r2 & 7;
            conv_tr64(p.in[I_WBR] + ((size_t)l * 4 + j) * 512 * 1024, 1024, ch * 64, kb * 64, 512, (bf16_t*)(p.ws + OFF_WBR) + (size_t)j * 1024 * 512 + (size_t)ch * 64 * 512, nullptr, lt, tid); continue; }
        it -= n_br;
        if (it < n_out) { const int ch = it >> 4, kb = it & 15;
            conv_tr64(p.in[I_WOUT] + (size_t)l * 1024 * 1024, 1024, ch * 64, kb * 64, 1024, (bf16_t*)(p.ws + OFF_WOUT) + (size_t)ch * 64 * 1024, nullptr, lt, tid); continue; }
        it -= n_out;
        if (it < n_pq) { const int ch = it >> 4, kb = it & 15;
            conv_tr64(p.in[I_PWQ] + (size_t)l * 1024 * 1024, 1024, ch * 64, kb * 64, 1024, (bf16_t*)(p.ws + OFF_WPQ) + (size_t)ch * 64 * 1024, nullptr, lt, tid); continue; }
        it -= n_pq;
        {
            const float* ks = p.in[I_PKEYS] + (size_t)l * 131072 + (size_t)it * 2048 + tid * 8;
            const f32x4 a = *(const f32x4*)ks, bq = *(const f32x4*)(ks + 4);
            u32x4 w = {pack2(a[0], a[1]), pack2(a[2], a[3]), pack2(bq[0], bq[1]), pack2(bq[2], bq[3])};
            *(u32x4*)((bf16_t*)(p.ws + KEYS_OFF(l)) + (size_t)it * 2048 + tid * 8) = w;
        }
    }
    __syncthreads();
}

#ifndef EB
#define EB 2
#endif
#define TROW 768
#ifndef FAKEIDX
#define FAKEIDX 0
#endif
#define DEPTH_ 2
#ifndef FOLD_ALL
#define FOLD_ALL 1
#endif
#ifndef CONVW_IN8
#define CONVW_IN8 0
#endif
#ifndef NODEC
#define NODEC 0
#endif
#ifndef SKIP
#define SKIP 0
#endif
__device__ __forceinline__ unsigned enc_e2m3(float x, float inv) {
    const float a = fabsf(x) * inv;
    float cf;
    if (a < 2.0f) cf = rintf(a * 8.0f); else if (a < 4.0f) cf = 16.0f + rintf((a - 2.0f) * 4.0f); else cf = 24.0f + rintf((a - 4.0f) * 2.0f);
    unsigned code = (unsigned)fminf(cf, 31.0f);
    return code | ((__float_as_uint(x) >> 31) << 5);
}
#define NCONV 512
__device__ __forceinline__ void conv_tables_item(const DP& p, int l, int item, int tid) {
    const int lane = tid & 63;
    const int j = lane >> 4, c = lane & 15;
    {
        const int tb = item >> 8;
        const int rbase = (item & 255) * 64 + (tid >> 6) * 16;
        const float* src = p.in[tb ? I_PV : I_PU] + (size_t)l * 16384 * 1024;
        unsigned char* dst = (unsigned char*)(p.ws + (tb ? OFF_TV : OFF_TU));
        float* scl = (float*)(p.ws + (tb ? OFF_SV : OFF_SU));
#pragma unroll 1
        for (int r0 = rbase; r0 < rbase + 16; r0 += 2) {
            f32x4 a[2][4];
#pragma unroll
            for (int rr = 0; rr < 2; ++rr)
#pragma unroll
                for (int q = 0; q < 4; ++q) a[rr][q] = *(const f32x4*)(src + (size_t)(r0 + rr) * 1024 + lane * 16 + q * 4);
#pragma unroll
            for (int rr = 0; rr < 2; ++rr) {
                float mx = 0.f;
#pragma unroll
                for (int q = 0; q < 4; ++q)
#pragma unroll
                    for (int i = 0; i < 4; ++i) mx = fmaxf(mx, fabsf(a[rr][q][i]));
#pragma unroll
                for (int o = 32; o >= 1; o >>= 1) mx = fmaxf(mx, __shfl_xor(mx, o));
                mx = fmaxf(mx, 1e-30f);
                const float inv = 7.5f / mx;
                unsigned d0 = 0u, d1 = 0u, d2 = 0u;
#pragma unroll
                for (int t = 0; t < 16; ++t) {
                    const unsigned code = enc_e2m3(a[rr][t >> 2][t & 3], inv);
                    const int bit = 6 * t, w = bit >> 5, sh = bit & 31;
                    if (w == 0) d0 |= code << sh; else if (w == 1) d1 |= code << sh; else d2 |= code << sh;
                    if (sh > 26) { if (w == 0) d1 |= code >> (32 - sh); else d2 |= code >> (32 - sh); }
                }
                unsigned char* o = dst + (size_t)(r0 + rr) * TROW + c * 16;
                const int n0 = 3 * j;
                *(unsigned*)(o + (n0 >> 2) * 256 + (n0 & 3) * 4) = d0;
                *(unsigned*)(o + ((n0 + 1) >> 2) * 256 + ((n0 + 1) & 3) * 4) = d1;
                *(unsigned*)(o + ((n0 + 2) >> 2) * 256 + ((n0 + 2) & 3) * 4) = d2;
                if (lane == 0) scl[r0 + rr] = mx * (1.0f / 7.5f);
            }
        }
    }
}

template <int BN, bool SWAP>
__device__ __forceinline__ void gemm_core(const bf16_t* __restrict__ A, int lda, const bf16_t* __restrict__ Bt, int ldb, int K,
                                          f32x4 (&acc)[4][BN / 32], char* lds, int tid,
                                          int& par, bool pre = false, const bf16_t* An = nullptr, int ldan = 0, const bf16_t* Bn = nullptr, int ldbn = 0) {
    constexpr int NF = BN / 32, NBL = BN / 32;
    const int lane = tid & 63, wid = tid >> 6, wr = wid >> 1, wc = wid & 1, g = lane >> 4, c = lane & 15;
    char* As = lds;
    char* Bs = lds + 32768;
    const int nk = K >> 6;
    const int srow = wid * 8 + (lane >> 3), scc = (lane & 7) ^ (lane >> 3);
    auto stage = [&](const bf16_t* Ab, int lda_, const bf16_t* Bb, int ldb_, int kt, int buf) {
        const bf16_t* a_src = Ab + (size_t)srow * lda_ + scc * 8;
        const bf16_t* b_src = Bb + (size_t)srow * ldb_ + scc * 8;
#pragma unroll
        for (int i = 0; i < 4; ++i)
            __builtin_amdgcn_global_load_lds((const unsigned*)(a_src + (size_t)i * 32 * lda_ + kt * 64), (LAS unsigned*)(As + buf * 16384 + (i * 4 + wid) * 1024), 16, 0, 0);
#pragma unroll
        for (int i = 0; i < NBL; ++i)
            __builtin_amdgcn_global_load_lds((const unsigned*)(b_src + (size_t)i * 32 * ldb_ + kt * 64), (LAS unsigned*)(Bs + buf * (BN * 128) + (i * 4 + wid) * 1024), 16, 0, 0);
    };
    const char* a_rd[2]; const char* b_rd[2];
#pragma unroll
    for (int kk = 0; kk < 2; ++kk) {
        a_rd[kk] = As + (wr * 64 + c) * 128 + (((kk * 4 + g) ^ (c & 7)) << 4);
        b_rd[kk] = Bs + (wc * (BN / 2) + c) * 128 + (((kk * 4 + g) ^ (c & 7)) << 4);
    }
    if (!pre) {
        __syncthreads();
        stage(A, lda, Bt, ldb, 0, par);
        asm volatile("s_waitcnt vmcnt(0)" ::: "memory");
        __syncthreads();
    }
    for (int kt = 0; kt < nk; ++kt) {
        const int buf = (par + kt) & 1;
        if (kt + 1 < nk) stage(A, lda, Bt, ldb, kt + 1, buf ^ 1);
        else if (An) stage(An, ldan, Bn, ldbn, 0, buf ^ 1);
#pragma unroll
        for (int kk = 0; kk < 2; ++kk) {
            bf16x8 af[4], bfr[NF];
#pragma unroll
            for (int m = 0; m < 4; ++m) af[m] = *(const bf16x8*)(a_rd[kk] + buf * 16384 + m * 2048);
#pragma unroll
            for (int n = 0; n < NF; ++n) bfr[n] = *(const bf16x8*)(b_rd[kk] + buf * (BN * 128) + n * 2048);
#pragma unroll
            for (int m = 0; m < 4; ++m)
#pragma unroll
                for (int n = 0; n < NF; ++n)
                    acc[m][n] = SWAP ? __builtin_amdgcn_mfma_f32_16x16x32_bf16(bfr[n], af[m], acc[m][n], 0, 0, 0)
                                     : __builtin_amdgcn_mfma_f32_16x16x32_bf16(af[m], bfr[n], acc[m][n], 0, 0, 0);
        }
        asm volatile("s_waitcnt vmcnt(0)" ::: "memory");
        __syncthreads();
    }
    par = (par + nk) & 1;
}

template <bool SWAP>
__device__ __forceinline__ void gemm256(const bf16_t* __restrict__ A, int lda, const bf16_t* __restrict__ Bt, int ldb, int K,
                                        f32x4 (&acc)[8][4], char* lds, int tid) {
    const int lane = tid & 63, wid = tid >> 6, wr = wid >> 1, wc = wid & 1, g = lane >> 4, c = lane & 15;
    const int nk = K >> 5;
    const int srow = wid * 16 + (lane >> 2), scc = ((lane & 3) + 2 * ((lane >> 4) & 3)) & 3;
    const bf16_t* a_src = A + (size_t)srow * lda + scc * 8;
    const bf16_t* b_src = Bt + (size_t)srow * ldb + scc * 8;
    auto stage = [&](int kt, int boff) {
#pragma unroll
        for (int i = 0; i < 4; ++i)
            __builtin_amdgcn_global_load_lds((const unsigned*)(a_src + (size_t)i * 64 * lda + kt * 32), (LAS unsigned*)(lds + boff + (i * 4 + wid) * 1024), 16, 0, 0);
#pragma unroll
        for (int i = 0; i < 2; ++i)
            __builtin_amdgcn_global_load_lds((const unsigned*)(b_src + (size_t)i * 64 * ldb + kt * 32), (LAS unsigned*)(lds + boff + 16384 + (i * 4 + wid) * 1024), 16, 0, 0);
    };
    const int slot = ((g + 2 * (c >> 2)) & 3) << 4;
    const char* a_rd = lds + (wr * 128 + c) * 64 + slot;
    const char* b_rd = lds + 16384 + (wc * 64 + c) * 64 + slot;
    __syncthreads();
    stage(0, 0);
    stage(1, 24576);
    int cur = 0, nxt2 = 49152;
    for (int kt = 0; kt < nk; ++kt) {
        if (kt + 1 < nk) asm volatile("s_waitcnt vmcnt(6)" ::: "memory"); else asm volatile("s_waitcnt vmcnt(0)" ::: "memory");
        __builtin_amdgcn_s_barrier();
        asm volatile("" ::: "memory");
        if (kt + 2 < nk) stage(kt + 2, nxt2);
        bf16x8 af[8], bfr[4];
#pragma unroll
        for (int m = 0; m < 8; ++m) af[m] = *(const bf16x8*)(a_rd + cur + m * 1024);
#pragma unroll
        for (int n = 0; n < 4; ++n) bfr[n] = *(const bf16x8*)(b_rd + cur + n * 1024);
#pragma unroll
        for (int m = 0; m < 8; ++m)
#pragma unroll
            for (int n = 0; n < 4; ++n)
                acc[m][n] = SWAP ? __builtin_amdgcn_mfma_f32_16x16x32_bf16(bfr[n], af[m], acc[m][n], 0, 0, 0)
                                 : __builtin_amdgcn_mfma_f32_16x16x32_bf16(af[m], bfr[n], acc[m][n], 0, 0, 0);
        nxt2 = cur; cur = (cur == 49152) ? 0 : cur + 24576;
    }
    asm volatile("s_waitcnt lgkmcnt(0)" ::: "memory");
}

template <int MF, int NF>
__device__ __forceinline__ void zero_acc(f32x4 (&acc)[MF][NF]) {
#pragma unroll
    for (int m = 0; m < MF; ++m)
#pragma unroll
        for (int n = 0; n < NF; ++n) acc[m][n] = (f32x4){0.f, 0.f, 0.f, 0.f};
}

#ifndef BKT
#define BKT 64
#endif
#define QSCALE64 (0.125f * LOG2E)
#define QSCALE192 (0.07216878364870322f * LOG2E)

struct TileIter {
    int x, lb, nlb, NT, RS, per, total, lt, NM; bool xcd;
    __device__ __forceinline__ void init(const DP& p, int NT_, int RS_, int NM_ = 144) {
        NT = NT_; RS = RS_; NM = NM_; xcd = (p.nblk & 7) == 0 && p.nblk >= 8;
        if (xcd) { x = p.bid & 7; lb = p.bid >> 3; nlb = p.nblk >> 3; per = RS * NT; total = (NM / 8) * NT; }
        else { x = 0; lb = p.bid; nlb = p.nblk; per = 1; total = NM * NT; }
        lt = lb;
    }
    __device__ __forceinline__ bool next(int& tm, int& tn) {
        if (lt >= total) return false;
        if (xcd) { const int rg = lt / per, rem = lt - rg * per; tn = rem / RS; const int r = rem - tn * RS; tm = (rg * RS + r) * 8 + x; }
        else { tn = lt / NM; tm = lt - tn * NM; }
        lt += nlb;
        return true;
    }
};

__device__ __forceinline__ void phase_inproj(const DP& p, int l, char* lds, int tid, int fake = 0) {
    const int lane = tid & 63, wid = tid >> 6, wr = wid >> 1, wc = wid & 1, g = lane >> 4, c = lane & 15;
    const bf16_t* HX = (const bf16_t*)(p.ws + OFF_HX);
    bf16_t* P = (bf16_t*)(p.ws + OFF_P);
    bf16_t* KB = (bf16_t*)(p.ws + OFF_KB);
    const float* lb = (const float*)(p.ws + OFF_LB);
    float rfreq[2][4];
#pragma unroll
    for (int H = 0; H < 2; ++H)
#pragma unroll
        for (int r = 0; r < 4; ++r) rfreq[H][r] = exp2f(-(float)(8 * (g & 1) + 4 * H + r) * (13.287712379549449f / 16.0f)) * 0.15915494309189535f;
    TileIter ti; ti.init(p, 42, 9, 72);
    int tm, tn_all;
    while (ti.next(tm, tn_all)) {
        if (tn_all < 21) {
            const int tn = tn_all;
            const int row0 = tm * 256, col0 = tn * 128;
            f32x4 acc[8][4]; zero_acc<8, 4>(acc);
            if (fake) {
                const int fr = (fake == 1) ? 0 : row0, fc = (fake == 1) ? 0 : col0;
                gemm256<true>(HX + (size_t)fr * DM, DM, (const bf16_t*)(p.ws + OFF_WIN) + (size_t)fc * DM, DM, DM, acc, lds, tid);
#pragma unroll
                for (int m = 0; m < 8; ++m)
#pragma unroll
                    for (int n = 0; n < 4; ++n) asm volatile("" :: "v"(acc[m][n]));
                continue;
            }
            gemm256<true>(HX + (size_t)row0 * DM, DM, (const bf16_t*)(p.ws + OFF_WIN) + (size_t)col0 * DM, DM, DM, acc, lds, tid);
            __syncthreads();
            const int chunk = (col0 >> 6) + wc;
            if (chunk >= 41) continue;
            const bool is_rope = (chunk < 16) || (chunk >= 30);
            const bool is_q = (chunk < 8) || (chunk >= 30 && chunk < 38);
            const int pcol = chunk * 64 + (chunk >= 22 ? 512 : 0);
            const int fA = g >> 1, fB = g & 1;
#pragma unroll
            for (int m = 0; m < 8; ++m) {
                const int row = row0 + wr * 128 + m * 16 + c;
                const int b = row / TU, t = row - b * TU;
                f32x4 v[4];
#pragma unroll
                for (int n = 0; n < 4; ++n) v[n] = acc[m][n];
                if (is_rope && t < SEQ) {
                    const float pos = (float)(fA == 0 ? (t >> 6) : (t & 63));
#pragma unroll
                    for (int H = 0; H < 2; ++H)
#pragma unroll
                        for (int r = 0; r < 4; ++r) {
                            const float a0 = pos * rfreq[H][r];
                            const float cs = __builtin_amdgcn_cosf(a0), sn = __builtin_amdgcn_sinf(a0);
                            const float x1 = v[H][r], x2 = v[2 + H][r];
                            v[H][r] = x1 * cs - x2 * sn; v[2 + H][r] = x1 * sn + x2 * cs;
                        }
                }
                if (is_q) {
#pragma unroll
                    for (int n = 0; n < 4; ++n) v[n] = v[n] * QSCALE64;
                }
#pragma unroll
                for (int P2 = 0; P2 < 2; ++P2) {
                    u32x4 w; w.x = pack2(v[2 * P2][0], v[2 * P2][1]); w.y = pack2(v[2 * P2][2], v[2 * P2][3]);
                    w.z = pack2(v[2 * P2 + 1][0], v[2 * P2 + 1][1]); w.w = pack2(v[2 * P2 + 1][2], v[2 * P2 + 1][3]);
                    const int fo = 32 * fA + 16 * P2 + 8 * fB;
                    if (chunk < 40) *(u32x4*)(P + (size_t)row * PW + pcol + fo) = w;
                    else {
#pragma unroll
                        for (int h = 0; h < 4; ++h) *(u32x4*)(KB + (size_t)row * 768 + h * 192 + 128 + fo) = w;
                    }
                }
            }
        } else {
            const int tn = tn_all - 21;
            const int row0 = tm * 256, col0 = tn * 128;
            f32x4 acc[8][4]; zero_acc<8, 4>(acc);
            if (fake) {
                const int fr = (fake == 1) ? 0 : row0, fc = (fake == 1) ? 0 : col0;
                gemm256<false>(HX + (size_t)fr * DM, DM, (const bf16_t*)(p.ws + OFF_WV) + (size_t)fc * DM, DM, DM, acc, lds, tid);
#pragma unroll
                for (int m = 0; m < 8; ++m)
#pragma unroll
                    for (int n = 0; n < 4; ++n) asm volatile("" :: "v"(acc[m][n]));
                continue;
            }
            gemm256<false>(HX + (size_t)row0 * DM, DM, (const bf16_t*)(p.ws + OFF_WV) + (size_t)col0 * DM, DM, DM, acc, lds, tid);
            const int chunk = (col0 >> 6) + wc;
#pragma unroll
            for (int m = 0; m < 8; ++m) {
                const int rowb = row0 + wr * 128 + m * 16 + 4 * g;
                const int b = rowb / TU, t = rowb - b * TU;
#pragma unroll
                for (int n = 0; n < 4; ++n) {
                    f32x4 v = acc[m][n];
                    bf16_t* dst;
                    if (chunk < 8) dst = (bf16_t*)(p.ws + OFF_VTA) + ((size_t)((b * 4 + (chunk >> 1)) * 128 + (chunk & 1) * 64 + n * 16 + c)) * TU + t;
                    else if (chunk < 10) dst = (bf16_t*)(p.ws + OFF_VTD) + ((size_t)((b * 2 + (chunk - 8)) * 64 + n * 16 + c)) * TU + t;
                    else {
                        const int ci = chunk - 10, arr = ci >> 3, col = (ci & 7) * 64 + n * 16 + c;
                        if (arr == 1 || arr == 2) {
                            const float lbv = lb[((arr - 1) * 2 + l) * 512 + col];
#pragma unroll
                            for (int r = 0; r < 4; ++r) v[r] = (1.0f - lbv) / (1.0f + __expf(v[r]));
                        }
                        dst = (bf16_t*)(p.ws + OFF_HT) + ((size_t)(((b * 4 + (col >> 7)) * 4 + arr) * 128 + (col & 127))) * TU + t;
                    }
                    u32x2 w; w.x = pack2(v[0], v[1]); w.y = pack2(v[2], v[3]);
                    *(u32x2*)dst = w;
                }
            }
        }
    }
}

__device__ __forceinline__ void row_rstd(const bf16_t* A, int lda, int K, float* rs, int tid) {
    __syncthreads();
    const int r = tid >> 1, half = tid & 1;
    const int n = K >> 1;
    const bf16_t* ap = A + (size_t)r * lda + half * n;
    float ss = 0.f;
    for (int i = 0; i < n; i += 8) {
        const u32x4 w = *(const u32x4*)(ap + i);
#pragma unroll
        for (int j = 0; j < 4; ++j) { const float a = bflo(w[j]), bq = bfhi(w[j]); ss += a * a + bq * bq; }
    }
    ss += __shfl_xor(ss, 1);
    if (half == 0) rs[r] = rsqrtf(ss / (float)K + 1e-6f);
    __syncthreads();
}

__device__ __forceinline__ void phase_mla(const DP& p, int l, char* lds, int tid) {
    const int lane = tid & 63, wid = tid >> 6, wr = wid >> 1, wc = wid & 1, g = lane >> 4, c = lane & 15;
    const bf16_t* P = (const bf16_t*)(p.ws + OFF_P);
    bf16_t* QB = (bf16_t*)(p.ws + OFF_QB);
    bf16_t* KB = (bf16_t*)(p.ws + OFF_KB);
    float rfreq[4];
#pragma unroll
    for (int r = 0; r < 4; ++r) rfreq[r] = exp2f(-(float)(4 * g + r) * (13.287712379549449f / 16.0f)) * 0.15915494309189535f;
    float* rs = (float*)(lds + LDS_MISC);
    TileIter ti; ti.init(p, 14, 18);
    int tm, tn_all;
    while (ti.next(tm, tn_all)) {
        if (tn_all < 6) {
            const int tn = tn_all, row0 = tm * 128, col0 = tn * 128;
            const bf16_t* A = P + (size_t)row0 * PW + PC_CQ;
            row_rstd(A, PW, 256, rs, tid);
            f32x4 acc[4][4]; zero_acc<4, 4>(acc);
            { int par0 = 0; gemm_core<128, true>(A, PW, (const bf16_t*)(p.ws + OFF_WUQ) + (size_t)col0 * 256, 256, 256, acc, lds, tid, par0); }
            const int chunk = (col0 >> 6) + wc;
            const bool is_rope = (chunk % 3) == 2;
#pragma unroll
            for (int m = 0; m < 4; ++m) {
                const int rl = wr * 64 + m * 16 + c, row = row0 + rl;
                const int b = row / TU, t = row - b * TU;
                const float sc = rs[rl] * QSCALE192;
                f32x4 v[4];
#pragma unroll
                for (int n = 0; n < 4; ++n) v[n] = acc[m][n] * sc;
                if (is_rope && t < SEQ) {
#pragma unroll
                    for (int r = 0; r < 4; ++r) {
                        const float fr = rfreq[r];
                        const float a0 = (float)(t >> 6) * fr, a1 = (float)(t & 63) * fr;
                        const float2 cs0 = make_float2(__builtin_amdgcn_cosf(a0), __builtin_amdgcn_sinf(a0)), cs1 = make_float2(__builtin_amdgcn_cosf(a1), __builtin_amdgcn_sinf(a1));
                        const float x1 = v[0][r], x2 = v[1][r], y1 = v[2][r], y2 = v[3][r];
                        v[0][r] = x1 * cs0.x - x2 * cs0.y; v[1][r] = x1 * cs0.y + x2 * cs0.x;
                        v[2][r] = y1 * cs1.x - y2 * cs1.y; v[3][r] = y1 * cs1.y + y2 * cs1.x;
                    }
                }
#pragma unroll
                for (int n = 0; n < 4; ++n) {
                    u32x2 w; w.x = pack2(v[n][0], v[n][1]); w.y = pack2(v[n][2], v[n][3]);
                    *(u32x2*)(QB + (size_t)row * 768 + chunk * 64 + n * 16 + 4 * g) = w;
                }
            }
        } else if (tn_all < 10) {
            const int tn = tn_all - 6, row0 = tm * 128, col0 = tn * 128;
            const bf16_t* A = P + (size_t)row0 * PW + PC_CKV;
            row_rstd(A, PW, 128, rs, tid);
            f32x4 acc[4][4]; zero_acc<4, 4>(acc);
            { int par0 = 0; gemm_core<128, true>(A, PW, (const bf16_t*)(p.ws + OFF_WUK) + (size_t)col0 * 128, 128, 128, acc, lds, tid, par0); }
#pragma unroll
            for (int m = 0; m < 4; ++m) {
                const int rl = wr * 64 + m * 16 + c, row = row0 + rl;
                const float sc = rs[rl];
#pragma unroll
                for (int n = 0; n < 4; ++n) {
                    const f32x4 v = acc[m][n] * sc;
                    u32x2 w; w.x = pack2(v[0], v[1]); w.y = pack2(v[2], v[3]);
                    *(u32x2*)(KB + (size_t)row * 768 + tn * 192 + wc * 64 + n * 16 + 4 * g) = w;
                }
            }
        } else {
            const int tn = tn_all - 10, row0 = tm * 128, col0 = tn * 128;
            const bf16_t* A = P + (size_t)row0 * PW + PC_CKV;
            row_rstd(A, PW, 128, rs, tid);
            f32x4 acc[4][4]; zero_acc<4, 4>(acc);
            { int par0 = 0; gemm_core<128, false>(A, PW, (const bf16_t*)(p.ws + OFF_WUV) + (size_t)col0 * 128, 128, 128, acc, lds, tid, par0); }
#pragma unroll
            for (int m = 0; m < 4; ++m) {
                const int rl = wr * 64 + m * 16 + 4 * g, rowb = row0 + rl;
                const int b = rowb / TU, t = rowb - b * TU;
                const float s0 = rs[rl], s1 = rs[rl + 1], s2 = rs[rl + 2], s3 = rs[rl + 3];
#pragma unroll
                for (int n = 0; n < 4; ++n) {
                    u32x2 w; w.x = pack2(acc[m][n][0] * s0, acc[m][n][1] * s1); w.y = pack2(acc[m][n][2] * s2, acc[m][n][3] * s3);
                    *(u32x2*)((bf16_t*)(p.ws + OFF_VTB) + ((size_t)((b * 4 + tn) * 128 + wc * 64 + n * 16 + c)) * TU + t) = w;
                }
            }
        }
    }
}

template <int DQK, int DV, int KT, bool WIN, int LDQ, int LDK, int LDO>
__device__ __forceinline__ void attn_item(const bf16_t* Qp, const bf16_t* __restrict__ Kp, const bf16_t* __restrict__ Vt, bf16_t* Op,
                          int seg0_start, int seg0_tiles, int seg1_start, int seg1_tiles, int qpos0,
                          float m_init, float l_init, char* lds, int tid) {
    constexpr int KS = DQK / 32, DT = DV / 16, NSUB = DQK / 64, NKT = KT / 16, NGRP = KT / 32;
    constexpr int KP = KT * 8 / 256;
    constexpr int NVC = DV * (KT / 8) / 256;
    constexpr int KROW = DQK * 2;
    const int lane = tid & 63, w = tid >> 6, g = lane >> 4, c = lane & 15;
    char* Ks = lds;
    char* Vs = lds + KT * KROW;
    bf16x8 qf[2][KS];
#pragma unroll
    for (int qt = 0; qt < 2; ++qt)
#pragma unroll
        for (int ks = 0; ks < KS; ++ks) qf[qt][ks] = *(const bf16x8*)(Qp + (size_t)(w * 32 + qt * 16 + c) * LDQ + ks * 32 + 8 * g);
    f32x4 O[DT][2];
#pragma unroll
    for (int dt = 0; dt < DT; ++dt) { O[dt][0] = (f32x4){0.f, 0.f, 0.f, 0.f}; O[dt][1] = (f32x4){0.f, 0.f, 0.f, 0.f}; }
    constexpr bool FOLD = FOLD_ALL || (DQK == 64 && DV == 128);
    constexpr bool LSUM = (DQK == 64 && DV == 128);
    float mrun[2] = {m_init, m_init};
    float lrun[2] = {g == 0 ? l_init : 0.f, g == 0 ? l_init : 0.f};
    f32x4 OL[2] = {(f32x4){l_init, l_init, l_init, l_init}, (f32x4){l_init, l_init, l_init, l_init}};

    const int ntiles = seg0_tiles + seg1_tiles;
    const int st_r = tid >> 3, st_cc = tid & 7;
    const bf16_t* kg_base = Kp + (size_t)st_r * LDK + st_cc * 8;
    char* kl_base = Ks + st_r * KROW + ((st_cc ^ (st_r & 7)) << 4);
    const bf16_t* vg_base; char* vl_base;
    if (KT == 64) { vg_base = Vt + (size_t)(tid >> 3) * TU + (tid & 7) * 8; vl_base = Vs + (tid >> 3) * 128 + (((tid & 7) ^ ((tid >> 3) & 7)) << 4); }
    else          { vg_base = Vt + (size_t)(tid >> 2) * TU + (tid & 3) * 8; vl_base = Vs + (tid >> 2) * 64 + (((tid & 3) ^ ((tid >> 4) & 3)) << 4); }
    const char* kf_base = Ks + (8 * (c >> 2) + (c & 3)) * KROW + ((g ^ (c & 3)) << 4);
    const char* vf_base0; const char* vf_base1;
    if (KT == 64) { vf_base0 = Vs + c * 128 + ((0 ^ ((c >> 2) & 1)) << 6) + ((g ^ (c & 3)) << 4); vf_base1 = Vs + c * 128 + ((1 ^ ((c >> 2) & 1)) << 6) + ((g ^ (c & 3)) << 4); }
    else          { vf_base0 = Vs + c * 64 + ((g ^ ((c >> 2) & 3)) << 4); vf_base1 = vf_base0; }
    u32x4 kreg[NSUB * KP], vreg[NVC];
    auto gload_k = [&](int ti) {
        const int key0 = ti < seg0_tiles ? seg0_start + KT * ti : seg1_start + KT * (ti - seg0_tiles);
        const bf16_t* kp = kg_base + (size_t)key0 * LDK;
#pragma unroll
        for (int sub = 0; sub < NSUB; ++sub)
#pragma unroll
            for (int i = 0; i < KP; ++i) kreg[sub * KP + i] = *(const u32x4*)(kp + (size_t)i * 32 * LDK + sub * 64);
    };
    auto gload_v = [&](int ti) {
        const int key0 = ti < seg0_tiles ? seg0_start + KT * ti : seg1_start + KT * (ti - seg0_tiles);
        const bf16_t* vp = vg_base + key0;
#pragma unroll
        for (int i = 0; i < NVC; ++i) vreg[i] = *(const u32x4*)(vp + (size_t)i * (KT == 64 ? 32 : 64) * TU);
    };
    auto gload = [&](int ti) { gload_k(ti); gload_v(ti); };
    auto lstore = [&]() {
#pragma unroll
        for (int sub = 0; sub < NSUB; ++sub)
#pragma unroll
            for (int i = 0; i < KP; ++i) *(u32x4*)(kl_base + i * 32 * KROW + sub * 128) = kreg[sub * KP + i];
#pragma unroll
        for (int i = 0; i < NVC; ++i) *(u32x4*)(vl_base + i * 4096) = vreg[i];
    };
    if (ntiles > 0) gload(0);
    for (int ti = 0; ti < ntiles; ++ti) {
        __syncthreads();
        lstore();
        __syncthreads();
        if (KS <= 2 && ti + 1 < ntiles) gload(ti + 1);
        f32x4 S[NKT][2];
        const float nb0 = (!FOLD || mrun[0] < -1e29f) ? 0.f : -mrun[0], nb1 = (!FOLD || mrun[1] < -1e29f) ? 0.f : -mrun[1];
#pragma unroll
        for (int kt = 0; kt < NKT; ++kt) { S[kt][0] = (f32x4){nb0, nb0, nb0, nb0}; S[kt][1] = (f32x4){nb1, nb1, nb1, nb1}; }
#pragma unroll
        for (int ks = 0; ks < KS; ++ks) {
#pragma unroll
            for (int kt = 0; kt < NKT; ++kt) {
                const bf16x8 kf = *(const bf16x8*)(kf_base + (32 * (kt >> 1) + 4 * (kt & 1)) * KROW + (ks >> 1) * 128 + (((ks & 1) ^ (kt & 1)) << 6));
                S[kt][0] = __builtin_amdgcn_mfma_f32_16x16x32_bf16(kf, qf[0][ks], S[kt][0], 0, 0, 0);
                S[kt][1] = __builtin_amdgcn_mfma_f32_16x16x32_bf16(kf, qf[1][ks], S[kt][1], 0, 0, 0);
            }
        }
        if (KS > 2 && ti + 1 < ntiles) gload_k(ti + 1);
        if (WIN && ti < seg0_tiles) {
            const int key0 = seg0_start + KT * ti;
#pragma unroll
            for (int qt = 0; qt < 2; ++qt) {
                const int qp = qpos0 + w * 32 + qt * 16 + c;
#pragma unroll
                for (int kt = 0; kt < NKT; ++kt)
#pragma unroll
                    for (int r = 0; r < 4; ++r) {
                        const int kp = key0 + 32 * (kt >> 1) + 8 * g + 4 * (kt & 1) + r;
                        const int d = kp - qp;
                        if (d > 128 || d < -128) S[kt][qt][r] = -1e30f;
                    }
            }
        }
        bf16x8 pf[2][NGRP];
#pragma unroll
        for (int qt = 0; qt < 2; ++qt) {
            float mx = S[0][qt][0];
#pragma unroll
            for (int kt = 0; kt < NKT; ++kt)
#pragma unroll
                for (int r = 0; r < 4; ++r) mx = fmaxf(mx, S[kt][qt][r]);
            mx = rows_max(mx);
            const float base = FOLD ? (qt ? -nb1 : -nb0) : 0.f;
            if (!__all(base + mx <= mrun[qt] + 8.0f)) {
                const float mnew = fmaxf(mrun[qt], base + mx);
                const float alpha = __builtin_amdgcn_exp2f(mrun[qt] - mnew);
                mrun[qt] = mnew;
                if (LSUM) OL[qt] = OL[qt] * alpha; else lrun[qt] *= alpha;
#pragma unroll
                for (int dt = 0; dt < DT; ++dt) O[dt][qt] = O[dt][qt] * alpha;
                if (FOLD) {
                    const float delta = mnew - base;
#pragma unroll
                    for (int kt = 0; kt < NKT; ++kt)
#pragma unroll
                        for (int r = 0; r < 4; ++r) S[kt][qt][r] -= delta;
                }
            }
            const float mcur = FOLD ? 0.f : mrun[qt];
            float ps = 0.f;
#pragma unroll
            for (int kt = 0; kt < NKT; ++kt)
#pragma unroll
                for (int r = 0; r < 4; ++r) { const float e = __builtin_amdgcn_exp2f(S[kt][qt][r] - mcur); S[kt][qt][r] = e; if (!LSUM) ps += e; }
            if (!LSUM) lrun[qt] += ps;
#pragma unroll
            for (int grp = 0; grp < NGRP; ++grp) {
                u32x4 pk;
                pk.x = pack2(S[2 * grp][qt][0], S[2 * grp][qt][1]); pk.y = pack2(S[2 * grp][qt][2], S[2 * grp][qt][3]);
                pk.z = pack2(S[2 * grp + 1][qt][0], S[2 * grp + 1][qt][1]); pk.w = pack2(S[2 * grp + 1][qt][2], S[2 * grp + 1][qt][3]);
                pf[qt][grp] = __builtin_bit_cast(bf16x8, pk);
            }
        }
        if (KS > 2 && ti + 1 < ntiles) gload_v(ti + 1);
#pragma unroll
        for (int dt = 0; dt < DT; ++dt)
#pragma unroll
            for (int grp = 0; grp < NGRP; ++grp) {
                const bf16x8 vf = *(const bf16x8*)((grp ? vf_base1 : vf_base0) + dt * 16 * (KT * 2));
                O[dt][0] = __builtin_amdgcn_mfma_f32_16x16x32_bf16(vf, pf[0][grp], O[dt][0], 0, 0, 0);
                O[dt][1] = __builtin_amdgcn_mfma_f32_16x16x32_bf16(vf, pf[1][grp], O[dt][1], 0, 0, 0);
            }
        if (LSUM) {
            unsigned one2 = 0x3F803F80u;
            asm volatile("" : "+v"(one2));
            const bf16x8 ones8 = __builtin_bit_cast(bf16x8, (u32x4){one2, one2, one2, one2});
#pragma unroll
            for (int grp = 0; grp < NGRP; ++grp) {
                OL[0] = __builtin_amdgcn_mfma_f32_16x16x32_bf16(ones8, pf[0][grp], OL[0], 0, 0, 0);
                OL[1] = __builtin_amdgcn_mfma_f32_16x16x32_bf16(ones8, pf[1][grp], OL[1], 0, 0, 0);
            }
        }
    }
#pragma unroll
    for (int qt = 0; qt < 2; ++qt) {
        float lt;
        if (LSUM) lt = OL[qt][0];
        else lt = rows_sum(lrun[qt]);
        const float inv = 1.0f / lt;
        bf16_t* op = Op + (size_t)(w * 32 + qt * 16 + c) * LDO + 4 * g;
#pragma unroll
        for (int dt = 0; dt < DT; ++dt) {
            const f32x4 o = O[dt][qt] * inv;
            u32x2 wv; wv.x = pack2(o[0], o[1]); wv.y = pack2(o[2], o[3]);
            *(u32x2*)(op + dt * 16) = wv;
        }
    }
}

#define HG_BUF 33280
__device__ __forceinline__ unsigned rot16(unsigned x) { return (x >> 16) | (x << 16); }

__device__ __forceinline__ void hgrn_item(const DP& p, int item, bool store_ctx, char* lds, int tid) {
    const int b = item >> 3, h = (item >> 1) & 3, dir = item & 1;
    const int lane = tid & 63, w = tid >> 6, g = lane >> 4, c = lane & 15;
    const bf16_t* HT = (const bf16_t*)(p.ws + OFF_HT) + (size_t)((b * 4 + h) * 4) * 128 * TU;
    const int ch = tid >> 1, half = tid & 1;
    const bf16_t* qrow = HT + (size_t)ch * TU;
    const bf16_t* krow = HT + (size_t)((1 + dir) * 128 + ch) * TU;
    const bf16_t* vrow = HT + (size_t)(3 * 128 + ch) * TU;
    bf16_t* Og = dir ? (bf16_t*)(p.ws + OFF_OHB) + (size_t)b * TU * 512 + h * 128 : (bf16_t*)(p.ws + OFF_P) + (size_t)b * TU * PW + PC_HOH + h * 128;
    const int ldo = dir ? 512 : PW;
    const int pch = (ch & ~31) | (((ch >> 2) & 3) << 3) | (((ch >> 4) & 1) << 2) | (ch & 3);
    const int q_wr = (pch & 7) * 2;
    const int q_chk = pch >> 3;
    const int kh_wr = ch * 64 + 8 * half;
    const int sw = (ch >> 1) & 3;
    int qk_rd[4];
#pragma unroll
    for (int ks = 0; ks < 4; ++ks) qk_rd[ks] = c * 256 + ((ks ^ (c >> 2)) << 6) + ((g ^ (c & 3)) << 4);
    const int kh_rd = 16384 + c * 64 + ((g ^ ((c >> 1) & 3)) << 4);
    const int vt_rd = 24576 + (32 * w + c) * 64 + ((g ^ ((c >> 1) & 3)) << 4);
    const int d_rd = 32768 + 16 * g;

    f32x4 S[8][2];
#pragma unroll
    for (int kt = 0; kt < 8; ++kt) { S[kt][0] = (f32x4){0.f, 0.f, 0.f, 0.f}; S[kt][1] = (f32x4){0.f, 0.f, 0.f, 0.f}; }

    u32x4 lq0, lq1, lk0, lk1, lv0, lv1;
    auto chunk_base = [&](int j) -> int {
        if (!dir) return j < 8 ? SEQ + 32 * j : 32 * (j - 8);
        return j < 8 ? SEQ + CTXL - 32 * (j + 1) : SEQ - 32 * (j - 7);
    };
    auto gload = [&](int j) {
        const int off = chunk_base(j) + (dir ? 16 * (1 - half) : 16 * half);
        lq0 = *(const u32x4*)(qrow + off); lq1 = *(const u32x4*)(qrow + off + 8);
        lk0 = *(const u32x4*)(krow + off); lk1 = *(const u32x4*)(krow + off + 8);
        lv0 = *(const u32x4*)(vrow + off); lv1 = *(const u32x4*)(vrow + off + 8);
    };
    auto prep = [&](char* B) {
        unsigned qw[8] = {lq0.x, lq0.y, lq0.z, lq0.w, lq1.x, lq1.y, lq1.z, lq1.w};
        unsigned kw[8] = {lk0.x, lk0.y, lk0.z, lk0.w, lk1.x, lk1.y, lk1.z, lk1.w};
        unsigned vw[8] = {lv0.x, lv0.y, lv0.z, lv0.w, lv1.x, lv1.y, lv1.z, lv1.w};
        if (dir) {
#pragma unroll
            for (int d = 0; d < 4; ++d) {
                unsigned t0 = rot16(qw[7 - d]); qw[7 - d] = rot16(qw[d]); qw[d] = t0;
                unsigned t1 = rot16(kw[7 - d]); kw[7 - d] = rot16(kw[d]); kw[d] = t1;
                unsigned t2 = rot16(vw[7 - d]); vw[7 - d] = rot16(vw[d]); vw[d] = t2;
            }
        }
        float bc[16]; float run = 0.f;
#pragma unroll
        for (int i = 0; i < 16; ++i) {
            const float kv = (i & 1) ? bfhi(kw[i >> 1]) : bflo(kw[i >> 1]);
            run += fmaxf(__builtin_amdgcn_logf(1.0f - kv), -126.0f);
            bc[i] = run;
        }
        const float oth = __shfl_xor(run, 1);
        const float bend = run + oth;
        const float add = half ? oth : 0.f;
        unsigned khw[8];
#pragma unroll
        for (int i = 0; i < 16; i += 2) {
            float qt[2], kt2[2], kh2[2];
#pragma unroll
            for (int e = 0; e < 2; ++e) {
                const float bb = bc[i + e] + add;
                const float bcl = fmaxf(bb, -120.0f);
                const float qv = e ? bfhi(qw[i >> 1]) : bflo(qw[i >> 1]);
                const float kv = e ? bfhi(kw[i >> 1]) : bflo(kw[i >> 1]);
                qt[e] = qv * __builtin_amdgcn_exp2f(bcl);
                kt2[e] = kv * __builtin_amdgcn_exp2f(-bcl);
                kh2[e] = kv * __builtin_amdgcn_exp2f(bend - bb);
                const int tau = 16 * half + i + e;
                const int a = tau * 256 + ((q_chk ^ (tau & 15)) << 4) + q_wr;
                *(bf16_t*)(B + a) = (bf16_t)f2bf(qt[e]);
                *(bf16_t*)(B + 8192 + a) = (bf16_t)f2bf(kt2[e]);
            }
            khw[i >> 1] = pack2(kh2[0], kh2[1]);
        }
#pragma unroll
        for (int gq = 0; gq < 4; ++gq) {
            u32x2 a; a.x = khw[2 * gq]; a.y = khw[2 * gq + 1];
            *(u32x2*)(B + 16384 + kh_wr + ((gq ^ sw) << 4)) = a;
            u32x2 v2; v2.x = vw[2 * gq]; v2.y = vw[2 * gq + 1];
            *(u32x2*)(B + 24576 + kh_wr + ((gq ^ sw) << 4)) = v2;
        }
        if (half == 0) *(float*)(B + 32768 + ch * 4) = __builtin_amdgcn_exp2f(bend);
    };

    __syncthreads();
    gload(0);
    prep(lds);
    __syncthreads();
    const int NCH = TU / 32;
    for (int j = 0; j < NCH; ++j) {
        const char* B = lds + (j & 1) * HG_BUF;
        if (j + 1 < NCH) gload(j + 1);
        f32x4 a00 = {0.f, 0.f, 0.f, 0.f}, a01 = {0.f, 0.f, 0.f, 0.f}, a11 = {0.f, 0.f, 0.f, 0.f};
        f32x4 o[2][2];
        o[0][0] = o[0][1] = o[1][0] = o[1][1] = (f32x4){0.f, 0.f, 0.f, 0.f};
#pragma unroll
        for (int ks = 0; ks < 4; ++ks) {
            const bf16x8 q0 = *(const bf16x8*)(B + qk_rd[ks]), q1 = *(const bf16x8*)(B + qk_rd[ks] + 4096);
            const bf16x8 k0 = *(const bf16x8*)(B + 8192 + qk_rd[ks]), k1 = *(const bf16x8*)(B + 8192 + qk_rd[ks] + 4096);
            a00 = __builtin_amdgcn_mfma_f32_16x16x32_bf16(k0, q0, a00, 0, 0, 0);
            a01 = __builtin_amdgcn_mfma_f32_16x16x32_bf16(k0, q1, a01, 0, 0, 0);
            a11 = __builtin_amdgcn_mfma_f32_16x16x32_bf16(k1, q1, a11, 0, 0, 0);
#pragma unroll
            for (int nv = 0; nv < 2; ++nv) {
                u32x4 sb;
                sb.x = pack2(S[2 * ks][nv][0], S[2 * ks][nv][1]); sb.y = pack2(S[2 * ks][nv][2], S[2 * ks][nv][3]);
                sb.z = pack2(S[2 * ks + 1][nv][0], S[2 * ks + 1][nv][1]); sb.w = pack2(S[2 * ks + 1][nv][2], S[2 * ks + 1][nv][3]);
                const bf16x8 sbf = __builtin_bit_cast(bf16x8, sb);
                o[0][nv] = __builtin_amdgcn_mfma_f32_16x16x32_bf16(q0, sbf, o[0][nv], 0, 0, 0);
                o[1][nv] = __builtin_amdgcn_mfma_f32_16x16x32_bf16(q1, sbf, o[1][nv], 0, 0, 0);
            }
        }
#pragma unroll
        for (int r = 0; r < 4; ++r) { if (4 * g + r > c) { a00[r] = 0.f; a11[r] = 0.f; } }
        u32x4 pa0, pa1;
        pa0.x = pack2(a00[0], a00[1]); pa0.y = pack2(a00[2], a00[3]); pa0.z = 0u; pa0.w = 0u;
        pa1.x = pack2(a01[0], a01[1]); pa1.y = pack2(a01[2], a01[3]); pa1.z = pack2(a11[0], a11[1]); pa1.w = pack2(a11[2], a11[3]);
        const bf16x8 vt0 = *(const bf16x8*)(B + vt_rd), vt1 = *(const bf16x8*)(B + vt_rd + 1024);
        o[0][0] = __builtin_amdgcn_mfma_f32_16x16x32_bf16(__builtin_bit_cast(bf16x8, pa0), vt0, o[0][0], 0, 0, 0);
        o[0][1] = __builtin_amdgcn_mfma_f32_16x16x32_bf16(__builtin_bit_cast(bf16x8, pa0), vt1, o[0][1], 0, 0, 0);
        o[1][0] = __builtin_amdgcn_mfma_f32_16x16x32_bf16(__builtin_bit_cast(bf16x8, pa1), vt0, o[1][0], 0, 0, 0);
        o[1][1] = __builtin_amdgcn_mfma_f32_16x16x32_bf16(__builtin_bit_cast(bf16x8, pa1), vt1, o[1][1], 0, 0, 0);
#pragma unroll
        for (int kt = 0; kt < 8; ++kt) {
            const f32x4 dv = *(const f32x4*)(B + d_rd + kt * 64);
            const bf16x8 khf = *(const bf16x8*)(B + kh_rd + kt * 1024);
            S[kt][0] = __builtin_amdgcn_mfma_f32_16x16x32_bf16(khf, vt0, S[kt][0] * dv, 0, 0, 0);
            S[kt][1] = __builtin_amdgcn_mfma_f32_16x16x32_bf16(khf, vt1, S[kt][1] * dv, 0, 0, 0);
        }
        {
            const int base = chunk_base(j);
#pragma unroll
            for (int tt = 0; tt < 2; ++tt)
#pragma unroll
                for (int r = 0; r < 4; ++r) {
                    const int tau = 16 * tt + 4 * g + r;
                    const int tok = dir ? base + 31 - tau : base + tau;
                    if (store_ctx || tok < SEQ) {
                        bf16_t* op = Og + (size_t)tok * ldo + 32 * w + c;
                        op[0] = (bf16_t)f2bf(o[tt][0][r]);
                        op[16] = (bf16_t)f2bf(o[tt][1][r]);
                    }
                }
        }
        if (j + 1 < NCH) prep(lds + ((j + 1) & 1) * HG_BUF);
        __syncthreads();
    }
}

#define QCTR_WORD(l) (3520 + 64 * (l))
__device__ __forceinline__ void phase_mixers(const DP& p, int l, char* lds, int tid, int mask) {
    const int nqb = (l == 0) ? 18 : 16;
    const int nBi = NB * 4 * nqb, nAi = NB * 8 * nqb, nDi = NB * 8 * nqb;
    if (mask & 1) for (int it = p.bid; it < 64; it += p.nblk) hgrn_item(p, it, l == 0, lds, tid);
    if (mask & 14) {
        const bool xq = (p.nblk & 7) == 0 && mask == 15;
        const int NX = xq ? 8 : 1, x = xq ? (p.bid & 7) : 0;
        const int nBx = nBi / NX, nAx = nAi / NX, nDx = nDi / NX;
        unsigned* ctr = (unsigned*)(p.ws + OFF_BAR) + QCTR_WORD(l) + (mask == 15 ? x : 16);
        volatile int* slot = (volatile int*)(lds + LDS_MISC + 992);
        for (;;) {
            __syncthreads();
            if (tid == 0) *slot = (int)atomicAdd(ctr, 1u);
            __syncthreads();
            const int it = *slot;
            int tl = tid;
            asm volatile("" : "+v"(tl));
            if (it >= nBx + nAx + nDx) break;
            if (it < nBx) {
                if (!(mask & 2)) continue;
                const int grp = it / nqb, qb = it - grp * nqb, G = grp * NX + x;
                const int h = G & 3, b = G >> 2;
                const int tok0 = qb < 16 ? qb * 128 : SEQ + (qb - 16) * 128;
                const size_t rowq = (size_t)b * TU + tok0;
                attn_item<192, 128, BKT, false, 768, 768, 512>((const bf16_t*)(p.ws + OFF_QB) + rowq * 768 + h * 192,
                                           (const bf16_t*)(p.ws + OFF_KB) + (size_t)b * TU * 768 + h * 192,
                                           (const bf16_t*)(p.ws + OFF_VTB) + (size_t)(b * 4 + h) * 128 * TU,
                                           (bf16_t*)(p.ws + OFF_OB) + rowq * 512 + h * 128,
                                           0, 0, qb < 16 ? 0 : SEQ, (qb < 16 ? TU : CTXL) / BKT, 0, -1e30f, 0.f, lds, tl);
            } else if (it < nBx + nAx) {
                if (!(mask & 4)) continue;
                const int j = it - nBx;
                const bf16_t* P = (const bf16_t*)(p.ws + OFF_P);
                const int grp = j / (2 * nqb), r = j - grp * 2 * nqb, sidx = r / nqb, qb = r - sidx * nqb, G = grp * NX + x;
                const int h = G & 3, b = G >> 2, hs = h * 2 + sidx;
                const int tok0 = qb < 16 ? qb * 128 : SEQ + (qb - 16) * 128;
                const size_t rowq = (size_t)b * TU + tok0;
                attn_item<64, 128, 64, false, PW, PW, 1024>(P + rowq * PW + PC_AQ + h * 128 + sidx * 64,
                                          P + (size_t)b * TU * PW + (sidx ? PC_AK2 : PC_AK1) + h * 64,
                                          (const bf16_t*)(p.ws + OFF_VTA) + (size_t)(b * 4 + h) * 128 * TU,
                                          (bf16_t*)(p.ws + OFF_OA12) + rowq * 1024 + hs * 128,
                                          0, 0, qb < 16 ? 0 : SEQ, qb < 16 ? 36 : 4, 0, -1e30f, 0.f, lds, tl);
            } else {
                if (!(mask & 8)) continue;
                const int j = it - nBx - nAx;
                const bf16_t* P = (const bf16_t*)(p.ws + OFF_P);
                const int grp = j / (4 * nqb), r = j - grp * 4 * nqb, hl = r / nqb, qb = r - hl * nqb, G = grp * NX + x;
                const int kvh = G & 1, b = G >> 1, hq = kvh * 4 + hl;
                const int tok0 = qb < 16 ? qb * 128 : SEQ + (qb - 16) * 128;
                const size_t rowq = (size_t)b * TU + tok0;
                int s0 = 0, n0 = 0;
                if (qb < 16) { s0 = qb * 128 - 128; if (s0 < 0) s0 = 0; int e0 = qb * 128 + 256; if (e0 > SEQ) e0 = SEQ; n0 = (e0 - s0) >> 6; }
                const float sink = p.in[I_SINK][l * 8 + hq] * LOG2E;
                bf16_t* qo = (bf16_t*)(p.ws + OFF_P) + rowq * PW + PC_DQ + hq * 64;
                attn_item<64, 64, 64, true, PW, PW, PW>(qo, P + (size_t)b * TU * PW + PC_DK + (hq >> 2) * 64,
                                        (const bf16_t*)(p.ws + OFF_VTD) + (size_t)(b * 2 + (hq >> 2)) * 64 * TU,
                                        qo, s0, n0, SEQ, 4, tok0, sink, 1.0f, lds, tl);
            }
        }
    }
}

__device__ __forceinline__ void phase_convq(const DP& p, int l, char* lds, int tid) {
    unsigned* ctr2 = (unsigned*)(p.ws + OFF_BAR) + QCTR_WORD(l) + 32;
    volatile int* slot = (volatile int*)(lds + LDS_MISC + 992);
    for (;;) {
        __syncthreads();
        if (tid == 0) *slot = (int)atomicAdd(ctr2, 1u);
        __syncthreads();
        const int it = *slot;
        if (it >= NCONV) break;
        int tl = tid;
        asm volatile("" : "+v"(tl));
        conv_tables_item(p, l, it, tl);
    }
}

__device__ __forceinline__ void phase_combine(const DP& p, int l, int tid) {
    const int lane = tid & 63;
    const int gw = p.bid * 4 + (tid >> 6), nw = p.nblk * 4;
    const float lam = ((const float*)(p.ws + OFF_LAM))[l * 2 + 0], lam_init = ((const float*)(p.ws + OFF_LAM))[l * 2 + 1];
    const int h = lane >> 4, d0 = (lane & 15) * 8;
    const float* dng = p.in[I_DNG] + l * 128 + d0;
    const float* hng = p.in[I_HNG] + l * 128 + d0;
    bf16_t* P = (bf16_t*)(p.ws + OFF_P);
    const bf16_t* OA = (const bf16_t*)(p.ws + OFF_OA12);
    const bf16_t* OBk = (const bf16_t*)(p.ws + OFF_OHB);
    for (int row = gw; row < RR; row += nw) {
        const int t = row % TU;
        if (l == 1 && t >= SEQ) continue;
        {
            const u32x4 a = *(const u32x4*)(OA + (size_t)row * 1024 + (h * 2 + 0) * 128 + d0);
            const u32x4 bq = *(const u32x4*)(OA + (size_t)row * 1024 + (h * 2 + 1) * 128 + d0);
            float o[8]; float ss = 0.f;
#pragma unroll
            for (int i = 0; i < 4; ++i) { o[2 * i] = bflo(a[i]) - lam * bflo(bq[i]); o[2 * i + 1] = bfhi(a[i]) - lam * bfhi(bq[i]); }
#pragma unroll
            for (int i = 0; i < 8; ++i) ss += o[i] * o[i];
            ss += __shfl_xor(ss, 1); ss += __shfl_xor(ss, 2); ss += __shfl_xor(ss, 4); ss += __shfl_xor(ss, 8);
            const float rstd = rsqrtf(ss * (1.0f / 128.0f) + 1e-6f) * (1.0f - lam_init);
            u32x4 w;
            w.x = pack2(o[0] * rstd * dng[0], o[1] * rstd * dng[1]); w.y = pack2(o[2] * rstd * dng[2], o[3] * rstd * dng[3]);
            w.z = pack2(o[4] * rstd * dng[4], o[5] * rstd * dng[5]); w.w = pack2(o[6] * rstd * dng[6], o[7] * rstd * dng[7]);
            *(u32x4*)(P + (size_t)row * PW + PC_AQ + h * 128 + d0) = w;
        }
        {
            const u32x4 a = *(const u32x4*)(P + (size_t)row * PW + PC_HOH + h * 128 + d0);
            const u32x4 bq = *(const u32x4*)(OBk + (size_t)row * 512 + h * 128 + d0);
            const u32x4 gg = *(const u32x4*)(P + (size_t)row * PW + PC_HG + h * 128 + d0);
            float o[8], gt[8]; float ss = 0.f;
#pragma unroll
            for (int i = 0; i < 4; ++i) { o[2 * i] = bflo(a[i]) + bflo(bq[i]); o[2 * i + 1] = bfhi(a[i]) + bfhi(bq[i]); gt[2 * i] = bflo(gg[i]); gt[2 * i + 1] = bfhi(gg[i]); }
#pragma unroll
            for (int i = 0; i < 8; ++i) ss += o[i] * o[i];
            ss += __shfl_xor(ss, 1); ss += __shfl_xor(ss, 2); ss += __shfl_xor(ss, 4); ss += __shfl_xor(ss, 8);
            const float rstd = rsqrtf(ss * (1.0f / 128.0f) + 1e-6f);
            float y[8];
#pragma unroll
            for (int i = 0; i < 8; ++i) y[i] = o[i] * rstd * hng[i] * siluf_(gt[i]);
            u32x4 w; w.x = pack2(y[0], y[1]); w.y = pack2(y[2], y[3]); w.z = pack2(y[4], y[5]); w.w = pack2(y[6], y[7]);
            *(u32x4*)(P + (size_t)row * PW + PC_HOH + h * 128 + d0) = w;
        }
    }
}

__device__ __forceinline__ void merge_branch_src(const DP& p, int j, int row0, const bf16_t*& A, int& lda) {
    const bf16_t* P = (const bf16_t*)(p.ws + OFF_P);
    if (j == 0) { A = P + (size_t)row0 * PW + PC_AQ; lda = PW; }
    else if (j == 1) { A = (const bf16_t*)(p.ws + OFF_OB) + (size_t)row0 * 512; lda = 512; }
    else if (j == 2) { A = P + (size_t)row0 * PW + PC_HOH; lda = PW; }
    else { A = P + (size_t)row0 * PW + PC_DQ; lda = PW; }
}
__device__ __forceinline__ void phase_merge(const DP& p, int l, char* lds, int tid) {
    const int lane = tid & 63, wid = tid >> 6, wr = wid >> 1, wc = wid & 1, g = lane >> 4, c = lane & 15;
    const bf16_t* HX = (const bf16_t*)(p.ws + OFF_HX);
    bf16_t* Y = (bf16_t*)(p.ws + OFF_Y);
    const bf16_t* WG = (const bf16_t*)(p.ws + OFF_WG);
    const bf16_t* WBR = (const bf16_t*)(p.ws + OFF_WBR);
    TileIter ti;
    if (l == DEPTH_ - 1) ti.init(p, 8, 4, 128); else ti.init(p, 8, 6);
    int tm, tn, tmn, tnn;
    bool have = false, haven = false;
    auto fetch = [&](int& a_tm, int& a_tn) -> bool { if (!ti.next(a_tm, a_tn)) return false; if (l == DEPTH_ - 1) a_tm = (a_tm >> 4) * 18 + (a_tm & 15); return true; };
    have = fetch(tm, tn);
    int par = 0; bool pre = false;
    while (have) {
        haven = fetch(tmn, tnn);
        const int row0 = tm * 128, col0 = tn * 128;
        u32x2 y[4][4];
#pragma unroll
        for (int m = 0; m < 4; ++m)
#pragma unroll
            for (int n = 0; n < 4; ++n) { y[m][n].x = 0u; y[m][n].y = 0u; }
#pragma unroll 1
        for (int j = 0; j < 4; ++j) {
            const bf16_t* Ab; int ldab; merge_branch_src(p, j, row0, Ab, ldab);
            const bf16_t* Bb = WBR + (size_t)j * 1024 * 512 + (size_t)col0 * 512;
            u32x2 sg[4][4];
            {
                f32x4 ag[4][4]; zero_acc<4, 4>(ag);
                gemm_core<128, true>(HX + (size_t)row0 * DM, DM, WG + (size_t)(j * 1024 + col0) * DM, DM, DM, ag, lds, tid, par, pre, Ab, ldab, Bb, 512);
#pragma unroll
                for (int m = 0; m < 4; ++m)
#pragma unroll
                    for (int n = 0; n < 4; ++n) {
                        float sv[4];
#pragma unroll
                        for (int r = 0; r < 4; ++r) sv[r] = 1.0f / (1.0f + __expf(-ag[m][n][r]));
                        sg[m][n].x = pack2(sv[0], sv[1]); sg[m][n].y = pack2(sv[2], sv[3]);
                    }
            }
            const bf16_t* An = nullptr; const bf16_t* Bn = nullptr;
            if (j < 3) { An = HX + (size_t)row0 * DM; Bn = WG + (size_t)((j + 1) * 1024 + col0) * DM; }
            else if (haven) { An = HX + (size_t)(tmn * 128) * DM; Bn = WG + (size_t)(tnn * 128) * DM; }
            f32x4 ab[4][4]; zero_acc<4, 4>(ab);
            gemm_core<128, true>(Ab, ldab, Bb, 512, 512, ab, lds, tid, par, true, An, DM, Bn, DM);
            pre = (An != nullptr);
#pragma unroll
            for (int m = 0; m < 4; ++m)
#pragma unroll
                for (int n = 0; n < 4; ++n) {
                    const float y0 = bflo(y[m][n].x) + ab[m][n][0] * bflo(sg[m][n].x), y1 = bfhi(y[m][n].x) + ab[m][n][1] * bfhi(sg[m][n].x);
                    const float y2 = bflo(y[m][n].y) + ab[m][n][2] * bflo(sg[m][n].y), y3 = bfhi(y[m][n].y) + ab[m][n][3] * bfhi(sg[m][n].y);
                    y[m][n].x = pack2(y0, y1); y[m][n].y = pack2(y2, y3);
                }
        }
#pragma unroll
        for (int m = 0; m < 4; ++m) {
            const int row = row0 + wr * 64 + m * 16 + c;
#pragma unroll
            for (int n = 0; n < 4; ++n)
                *(u32x2*)(Y + (size_t)row * DM + col0 + wc * 64 + n * 16 + 4 * g) = y[m][n];
        }
        have = haven; tm = tmn; tn = tnn;
    }
}

__device__ __forceinline__ void phase_wout(const DP& p, int l, char* lds, int tid) {
    const int lane = tid & 63, wid = tid >> 6, wr = wid >> 1, wc = wid & 1, g = lane >> 4, c = lane & 15;
    const bf16_t* Y = (const bf16_t*)(p.ws + OFF_Y);
    float* X = (float*)(p.ws + OFF_X);
    const float* mod = (const float*)(p.ws + OFF_MOD) + (size_t)l * 9 * 6144;
    TileIter ti;
    if (l == DEPTH_ - 1) ti.init(p, 8, 8, 64); else ti.init(p, 8, 9, 72);
    int tm, tn;
    while (ti.next(tm, tn)) {
        if (l == DEPTH_ - 1) tm = (tm >> 3) * 9 + (tm & 7);
        const int row0 = tm * 256, col0 = tn * 128;
        const bool isctx = (tm % 9) == 8;
        f32x4 acc[8][4]; zero_acc<8, 4>(acc);
        gemm256<true>(Y + (size_t)row0 * DM, DM, (const bf16_t*)(p.ws + OFF_WOUT) + (size_t)col0 * DM, DM, DM, acc, lds, tid);
        const float* gate = mod + (isctx ? 8 : (tm / 9)) * 6144 + 2 * 1024;
#pragma unroll
        for (int m = 0; m < 8; ++m) {
            const int row = row0 + wr * 128 + m * 16 + c;
#pragma unroll
            for (int n = 0; n < 4; ++n) {
                const int col = col0 + wc * 64 + n * 16 + 4 * g;
                const f32x4 gt = *(const f32x4*)(gate + col);
                f32x4* xp = (f32x4*)(X + (size_t)row * DM + col);
                *xp = *xp + gt * acc[m][n];
            }
        }
    }
}

__device__ __forceinline__ void phase_peerq(const DP& p, int l, char* lds, int tid) {
    const int lane = tid & 63, wid = tid >> 6, wr = wid >> 1, wc = wid & 1, g = lane >> 4, c = lane & 15;
    const bf16_t* HX = (const bf16_t*)(p.ws + OFF_HX);
    bf16_t* PQ = (bf16_t*)(p.ws + OFF_PQ);
    TileIter ti;
    if (l == DEPTH_ - 1) ti.init(p, 8, 8, 64); else ti.init(p, 8, 9, 72);
    int tm, tn;
    while (ti.next(tm, tn)) {
        if (l == DEPTH_ - 1) tm = (tm >> 3) * 9 + (tm & 7);
        const int row0 = tm * 256, col0 = tn * 128;
        f32x4 acc[8][4]; zero_acc<8, 4>(acc);
        gemm256<true>(HX + (size_t)row0 * DM, DM, (const bf16_t*)(p.ws + OFF_WPQ) + (size_t)col0 * DM, DM, DM, acc, lds, tid);
#pragma unroll
        for (int m = 0; m < 8; ++m) {
            const int row = row0 + wr * 128 + m * 16 + c;
#pragma unroll
            for (int n = 0; n < 4; ++n) {
                u32x2 w; w.x = pack2(acc[m][n][0], acc[m][n][1]); w.y = pack2(acc[m][n][2], acc[m][n][3]);
                *(u32x2*)(PQ + (size_t)row * DM + col0 + wc * 64 + n * 16 + 4 * g) = w;
            }
        }
    }
}

__device__ __forceinline__ unsigned ord_key(float f) { const unsigned u = __float_as_uint(f); return (u & 0x80000000u) ? ~u : (u | 0x80000000u); }
__device__ __forceinline__ float ord_val(unsigned k) { const unsigned u = (k & 0x80000000u) ? (k & 0x7fffffffu) : ~k; return __uint_as_float(u); }
template <int CTRL> __device__ __forceinline__ unsigned dpp_u(unsigned x) { return (unsigned)__builtin_amdgcn_mov_dpp((int)x, CTRL, 0xf, 0xf, true); }
template <int CTRL> __device__ __forceinline__ float dpp_f(float x) { return __builtin_bit_cast(float, __builtin_amdgcn_mov_dpp(__builtin_bit_cast(int, x), CTRL, 0xf, 0xf, true)); }
__device__ __forceinline__ unsigned row_max_u32(unsigned v) {
    v = max(v, dpp_u<0xB1>(v)); v = max(v, dpp_u<0x4E>(v)); v = max(v, dpp_u<0x141>(v)); v = max(v, dpp_u<0x128>(v));
    return v;
}
__device__ __forceinline__ float row_sum_f32(float v) {
    v += dpp_f<0xB1>(v); v += dpp_f<0x4E>(v); v += dpp_f<0x141>(v); v += dpp_f<0x128>(v);
    return v;
}

template <int NR>
__device__ __forceinline__ void peer_topk(unsigned (&sk)[NR][2][8], int lane, int c, int* pi, float* pg, int pstride) {
    unsigned mine[NR][2];
#pragma unroll
    for (int r = 0; r < NR; ++r) { mine[r][0] = 0u; mine[r][1] = 0u; }
#pragma unroll 1
    for (int rnd = 0; rnd < 16; ++rnd) {
#pragma unroll
        for (int r = 0; r < NR; ++r)
#pragma unroll
            for (int pp = 0; pp < 2; ++pp) {
                unsigned m = sk[r][pp][0];
#pragma unroll
                for (int nf = 1; nf < 8; ++nf) m = max(m, sk[r][pp][nf]);
                m = row_max_u32(m);
#pragma unroll
                for (int nf = 0; nf < 8; ++nf) sk[r][pp][nf] = (sk[r][pp][nf] == m) ? 0u : sk[r][pp][nf];
                if (c == rnd) mine[r][pp] = m;
            }
    }
    float sv[NR][2]; int si[NR][2];
#pragma unroll
    for (int r = 0; r < NR; ++r)
#pragma unroll
        for (int pp = 0; pp < 2; ++pp) { sv[r][pp] = ord_val(mine[r][pp] & ~127u); si[r][pp] = 127 - (int)(mine[r][pp] & 127u); }
    int ptr[NR]; unsigned minec[NR];
#pragma unroll
    for (int r = 0; r < NR; ++r) { ptr[r] = 0; minec[r] = 0u; }
#pragma unroll 1
    for (int rnd = 0; rnd < 16; ++rnd) {
#pragma unroll
        for (int r = 0; r < NR; ++r) {
            const float s0 = __shfl(sv[r][0], (lane & 48) | (ptr[r] & 15));
            const float cv = s0 + sv[r][1];
            unsigned key = (ptr[r] < 16) ? ((ord_key(cv) & ~255u) | (unsigned)(255 - (ptr[r] * 16 + c))) : 0u;
            const unsigned m = row_max_u32(key);
            if (key == m) ptr[r]++;
            if (c == rnd) minec[r] = m;
        }
    }
#pragma unroll
    for (int r = 0; r < NR; ++r) {
        const int flat = 255 - (int)(minec[r] & 255u);
        const int ei = flat >> 4, ej = flat & 15;
        const float tsv = __shfl(sv[r][0], (lane & 48) | ei) + __shfl(sv[r][1], (lane & 48) | ej);
        const int eidx = __shfl(si[r][0], (lane & 48) | ei) * 128 + __shfl(si[r][1], (lane & 48) | ej);
        const float tmax = ord_val(row_max_u32(ord_key(tsv)));
        const float ex = __expf(tsv - tmax);
        pi[r * pstride] = eidx;
        pg[r * pstride] = ex / row_sum_f32(ex);
    }
}

template <bool nostore, bool Q>
__device__ __forceinline__ void peer_item(const DP& p, int l, char* lds, int tid, int row0) {
    typedef float f32x2 __attribute__((ext_vector_type(2)));
    typedef unsigned v6u __attribute__((ext_vector_type(6)));
    typedef float v32f __attribute__((ext_vector_type(32)));
    const int wid = tid >> 6;
    const bf16_t* H2 = (const bf16_t*)(p.ws + OFF_HX);
    const bf16_t* PQ = (const bf16_t*)(p.ws + OFF_PQ);
    const bf16_t* KEYS = (const bf16_t*)(p.ws + KEYS_OFF(l));
    const unsigned char* TUu = (const unsigned char*)(p.ws + OFF_TU);
    const unsigned char* TVv = (const unsigned char*)(p.ws + OFF_TV);
    const float* SUs = (const float*)(p.ws + OFF_SU);
    const float* SVs = (const float*)(p.ws + OFF_SV);
    float* X = (float*)(p.ws + OFF_X);
    const float* mod = (const float*)(p.ws + OFF_MOD) + (size_t)l * 9 * 6144;
    int* park_i = (int*)lds;
    float* park_g = (float*)(lds + 8192);
    {
        int lane = tid & 63;
        asm volatile("" : "+v"(lane));
        const int g = lane >> 4, c = lane & 15;
#pragma unroll 1
        for (int hh = 0; hh < 2; ++hh) {
            const int h = wid * 2 + hh;
            int cl = c, gl = g;
            asm volatile("" : "+v"(cl)); asm volatile("" : "+v"(gl));
            f32x4 sacc[2][8];
#pragma unroll
            for (int pp = 0; pp < 2; ++pp) {
#pragma unroll
                for (int nf = 0; nf < 8; ++nf) sacc[pp][nf] = (f32x4){0.f, 0.f, 0.f, 0.f};
#pragma unroll
                for (int ks = 0; ks < 2; ++ks) {
                    const bf16x8 af = *(const bf16x8*)(PQ + (size_t)(row0 + (Q ? (cl >> 2) : cl)) * DM + (h * 2 + pp) * 64 + ks * 32 + 8 * gl);
#pragma unroll
                    for (int nf = 0; nf < 8; ++nf) {
                        const bf16x8 bfr = *(const bf16x8*)(KEYS + (size_t)((h * 2 + pp) * 128 + nf * 16 + cl) * 64 + ks * 32 + 8 * gl);
                        sacc[pp][nf] = __builtin_amdgcn_mfma_f32_16x16x32_bf16(af, bfr, sacc[pp][nf], 0, 0, 0);
                    }
                }
            }
            {
                constexpr int NR = Q ? 1 : 4;
                unsigned sk[NR][2][8];
#pragma unroll
                for (int r = 0; r < NR; ++r)
#pragma unroll
                    for (int pp = 0; pp < 2; ++pp)
#pragma unroll
                        for (int nf = 0; nf < 8; ++nf) sk[r][pp][nf] = (ord_key(sacc[pp][nf][r]) & ~127u) | (unsigned)(127 - (nf * 16 + c));
                const int pidx = (h * 16 + (Q ? g : 4 * g)) * 16 + c;
                peer_topk<NR>(sk, lane, c, park_i + pidx, park_g + pidx, 16);
            }
        }
        __syncthreads();
        const int ts = Q ? wid : 4 * wid + g;
        const int row = row0 + ts;
        const int bb = row / TU, tt = row - bb * TU;
        const int pb0 = ts * 16;
        constexpr int NG = (Q ? 16 : 64) * 2 / EB;
#define PEER_HD(G_) (Q ? 2 * g + ((G_) >> 3) : ((G_) >> 3))
#define PEER_GC(G_) ((G_) < NG ? (G_) : NG - 1)
#define PEER_IDS(ids_, G_) { _Pragma("unroll") for (int r = 0; r < EB; ++r) \
                ids_[r] = park_i[PEER_HD(PEER_GC(G_)) * 256 + pb0 + (PEER_GC(G_) & 7) * EB + r] & ((FAKEIDX && nostore) ? FAKEIDX : 0xffffff); }
#define PEER_WTS(w_, G_) { _Pragma("unroll") for (int r = 0; r < EB; ++r) w_[r] = park_g[PEER_HD(PEER_GC(G_)) * 256 + pb0 + (PEER_GC(G_) & 7) * EB + r]; }
#define PEER_ROWS(T_, buf_, ids_) { \
            _Pragma("unroll") for (int r = 0; r < EB; ++r) { \
                const unsigned char* rp_ = T_ + (size_t)ids_[r] * TROW + c * 16; \
                _Pragma("unroll") for (int j = 0; j < 3; ++j) buf_[r][j] = *(const u32x4*)(rp_ + j * 256); } }
#define PEER_GQ(buf_, r_, k_) v6u gq; \
            if (k_ == 0) { gq[0] = buf_[r_][0][0]; gq[1] = buf_[r_][0][1]; gq[2] = buf_[r_][0][2]; gq[3] = buf_[r_][0][3]; gq[4] = buf_[r_][1][0]; gq[5] = buf_[r_][1][1]; } \
            else         { gq[0] = buf_[r_][1][2]; gq[1] = buf_[r_][1][3]; gq[2] = buf_[r_][2][0]; gq[3] = buf_[r_][2][1]; gq[4] = buf_[r_][2][2]; gq[5] = buf_[r_][2][3]; }
        {
            f32x2 hf2[32];
#pragma unroll
            for (int j = 0; j < 4; ++j) {
                const u32x4 a = *(const u32x4*)(H2 + (size_t)row * DM + j * 256 + c * 16), bq = *(const u32x4*)(H2 + (size_t)row * DM + j * 256 + c * 16 + 8);
#pragma unroll
                for (int q = 0; q < 4; ++q) { hf2[j * 8 + q] = (f32x2){bflo(a[q]), bfhi(a[q])}; hf2[j * 8 + 4 + q] = (f32x2){bflo(bq[q]), bfhi(bq[q])}; }
            }
            float myw = 0.f;
            u32x4 ua[2][EB][3];
#define PEER_UCOMP(buf_, G_) { \
            f32x2 d2[EB], e2[EB]; \
            _Pragma("unroll") for (int r = 0; r < EB; ++r) { d2[r] = (f32x2){0.f, 0.f}; e2[r] = (f32x2){0.f, 0.f}; } \
            _Pragma("unroll") for (int k = 0; k < 2; ++k) { \
                _Pragma("unroll") for (int r = 0; r < EB; ++r) { \
                    PEER_GQ(buf_, r, k) \
                    asm volatile("" : "+v"(gq[0]) : "v"(d2[(r + EB - 1) % EB])); \
                    v32f dv; \
                    if (NODEC && nostore) { _Pragma("unroll") for (int i = 0; i < 32; ++i) dv[i] = __uint_as_float(gq[i % 6]); } \
                    else dv = __builtin_amdgcn_cvt_scalef32_pk32_f32_fp6(gq, 1.0f); \
                    _Pragma("unroll") for (int i = 0; i < 16; i += 2) { \
                        d2[r] = __builtin_elementwise_fma((f32x2){dv[2 * i], dv[2 * i + 1]}, hf2[k * 16 + i], d2[r]); \
                        e2[r] = __builtin_elementwise_fma((f32x2){dv[2 * i + 2], dv[2 * i + 3]}, hf2[k * 16 + i + 1], e2[r]); } \
                    __builtin_amdgcn_sched_barrier(0); } } \
            _Pragma("unroll") for (int r = 0; r < EB; ++r) { \
                const float dd = row_sum_f32((d2[r].x + d2[r].y) + (e2[r].x + e2[r].y)); \
                if (c == ((G_) & 7) * EB + r) myw = dd; } \
            if (((G_) & 7) == 7) {                            \
                const int pi_ = PEER_HD(G_) * 256 + pb0 + c; \
                const int eidx = park_i[pi_]; \
                const float x_ = myw * SUs[eidx]; \
                const float act = 0.5f * x_ * (1.0f + erff(x_ * 0.70710678118654752f)); \
                park_g[pi_] = park_g[pi_] * act * SVs[eidx]; } }
            int idA[EB], idB[EB];
            PEER_IDS(idA, 0); PEER_ROWS(TUu, ua[0], idA); PEER_IDS(idB, 1);
#pragma unroll 1
            for (int G = 0; G < NG; G += 2) {
                PEER_ROWS(TUu, ua[1], idB); PEER_IDS(idA, G + 2);
                __builtin_amdgcn_sched_barrier(0);
                PEER_UCOMP(ua[0], G);
                __builtin_amdgcn_sched_barrier(0);
                PEER_ROWS(TUu, ua[0], idA);
                PEER_IDS(idB, G + 3);
                __builtin_amdgcn_sched_barrier(0);
                PEER_UCOMP(ua[1], G + 1);
                __builtin_amdgcn_sched_barrier(0);
            }
#undef PEER_UCOMP
        }
        float outv[64];
#pragma unroll
        for (int i = 0; i < 64; ++i) outv[i] = 0.f;
        {
            u32x4 va[2][EB][3];
#define PEER_VCOMP(buf_, wr) { \
            _Pragma("unroll") for (int k = 0; k < 2; ++k) { \
                _Pragma("unroll") for (int r = 0; r < EB; ++r) { \
                    PEER_GQ(buf_, r, k) \
                    asm volatile("" : "+v"(gq[0]) : "v"(outv[k * 32 + 31])); \
                    v32f dv; \
                    if (NODEC && nostore) { _Pragma("unroll") for (int i = 0; i < 32; ++i) dv[i] = __uint_as_float(gq[i % 6]); } \
                    else dv = __builtin_amdgcn_cvt_scalef32_pk32_f32_fp6(gq, 1.0f); \
                    _Pragma("unroll") for (int i = 0; i < 32; ++i) outv[k * 32 + i] += wr[r] * dv[i]; \
                    __builtin_amdgcn_sched_barrier(0); } } }
            int idA[EB], idB[EB]; float w0[EB], w1[EB];
            PEER_IDS(idA, 0); PEER_ROWS(TVv, va[0], idA); PEER_IDS(idB, 1); PEER_WTS(w0, 0);
#pragma unroll 1
            for (int G = 0; G < NG; G += 2) {
                PEER_ROWS(TVv, va[1], idB); PEER_IDS(idA, G + 2); PEER_WTS(w1, G + 1);
                __builtin_amdgcn_sched_barrier(0);
                PEER_VCOMP(va[0], w0);
                __builtin_amdgcn_sched_barrier(0);
                if (G + 2 < NG) PEER_ROWS(TVv, va[0], idA);
                PEER_IDS(idB, G + 3); PEER_WTS(w0, G + 2);
                __builtin_amdgcn_sched_barrier(0);
                PEER_VCOMP(va[1], w1);
                __builtin_amdgcn_sched_barrier(0);
            }
#undef PEER_VCOMP
        }
#undef PEER_ROWS
#undef PEER_IDS
#undef PEER_WTS
#undef PEER_GC
#undef PEER_GQ
#undef PEER_HD
        if (Q) {
#pragma unroll
            for (int i = 0; i < 64; ++i) { outv[i] += __shfl_xor(outv[i], 16); outv[i] += __shfl_xor(outv[i], 32); }
        }
        if (nostore) {
#pragma unroll
            for (int i = 0; i < 64; ++i) asm volatile("" :: "v"(outv[i]));
        } else {
            const float* gate = mod + (tt >= SEQ ? 8 : bb) * 6144 + 5 * 1024;
            int rowl = row;
            asm volatile("" : "+v"(rowl));
            float ss = 0.f;
#pragma unroll
            for (int j = 0; j < 4; ++j) {
#pragma unroll
                for (int q = 0; q < 4; ++q) {
                    const int col = j * 256 + c * 16 + 4 * q;
                    const f32x4 g0 = *(const f32x4*)(gate + col);
                    f32x4* xp = (f32x4*)(X + (size_t)rowl * DM + col);
                    f32x4 x0 = *xp;
#pragma unroll
                    for (int i = 0; i < 4; ++i) { x0[i] += g0[i] * outv[j * 16 + 4 * q + i]; outv[j * 16 + 4 * q + i] = x0[i]; ss += x0[i] * x0[i]; }
                    if (l != DEPTH_ - 1 && (!Q || j == g)) *xp = x0;
                }
                __builtin_amdgcn_sched_barrier(0);
            }
            if (l != DEPTH_ - 1) {
                const float rstd = rsqrtf(row_sum_f32(ss) * (1.0f / 1024.0f) + 1e-6f);
                const float* gvec = p.in[I_N1G] + (l + 1) * DM;
                const float* mrow = mod + 9 * 6144 + (tt >= SEQ ? 8 : bb) * 6144;
                bf16_t* hrow = (bf16_t*)(p.ws + OFF_HX) + (size_t)row * DM;
#pragma unroll
                for (int j = 0; j < 4; ++j) {
                    if (!Q || j == g) {
#pragma unroll
                        for (int q = 0; q < 4; ++q) {
                            const int col = j * 256 + c * 16 + 4 * q;
                            const f32x4 g4 = *(const f32x4*)(gvec + col);
                            const f32x4 sh = *(const f32x4*)(mrow + col);
                            const f32x4 sc = *(const f32x4*)(mrow + 1024 + col);
                            float y[4];
#pragma unroll
                            for (int i = 0; i < 4; ++i) y[i] = outv[j * 16 + 4 * q + i] * rstd * g4[i] * (1.0f + sc[i]) + sh[i];
                            u32x2 w; w.x = pack2(y[0], y[1]); w.y = pack2(y[2], y[3]);
                            *(u32x2*)(hrow + col) = w;
                        }
                    }
                    __builtin_amdgcn_sched_barrier(0);
                }
            }
            if (l == DEPTH_ - 1) {
                const float rstd = rsqrtf(row_sum_f32(ss) * (1.0f / 1024.0f) + 1e-6f);
                const float* fg = p.in[I_FG];
                float* orow = p.out + (size_t)(bb * SEQ + tt) * DM;
#pragma unroll
                for (int j = 0; j < 4; ++j) {
                    if (!Q || j == g) {
#pragma unroll
                        for (int q = 0; q < 4; ++q) {
                            const int col = j * 256 + c * 16 + 4 * q;
                            const f32x4 f4 = *(const f32x4*)(fg + col);
                            f32x4 o4;
#pragma unroll
                            for (int i = 0; i < 4; ++i) o4[i] = outv[j * 16 + 4 * q + i] * rstd * f4[i];
                            *(f32x4*)(orow + col) = o4;
                        }
                    }
                    __builtin_amdgcn_sched_barrier(0);
                }
            }
        }
        __syncthreads();
    }
}

template <bool nostore>
__device__ __forceinline__ void phase_peer(const DP& p, int l, char* lds, int tid) {
    const int nbi = (l == 0) ? RR / 16 : NB * SEQ / 16;
    const int nfull = (nbi / p.nblk) * p.nblk;
    for (int bi = p.bid; bi < nfull; bi += p.nblk) {
        int row0;
        if (l == 0) row0 = bi * 16; else { const int b = bi / (SEQ / 16); row0 = b * TU + (bi % (SEQ / 16)) * 16; }
        peer_item<nostore, false>(p, l, lds, tid, row0);
    }
    for (int qi = p.bid; qi < (nbi - nfull) * 4; qi += p.nblk) {
        const int bi = nfull + (qi >> 2);
        int row0;
        if (l == 0) row0 = bi * 16; else { const int b = bi / (SEQ / 16); row0 = b * TU + (bi % (SEQ / 16)) * 16; }
        peer_item<nostore, true>(p, l, lds, tid, row0 + (qi & 3) * 4);
    }
}

__device__ __forceinline__ void phase_final(const DP& p, int tid) {
    const int lane = tid & 63;
    const int gw = p.bid * 4 + (tid >> 6), nw = p.nblk * 4;
    const float* X = (const float*)(p.ws + OFF_X);
    const float* fg = p.in[I_FG];
    for (int r = gw; r < NB * SEQ; r += nw) {
        const int b = r / SEQ, t = r - b * SEQ;
        const float* src = X + (size_t)(b * TU + t) * DM;
        f32x4 v[4]; float ss = 0.f;
#pragma unroll
        for (int j = 0; j < 4; ++j) { v[j] = *(const f32x4*)(src + j * 256 + lane * 4); ss += v[j][0] * v[j][0] + v[j][1] * v[j][1] + v[j][2] * v[j][2] + v[j][3] * v[j][3]; }
        ss = wave_sum(ss);
        const float rstd = rsqrtf(ss * (1.0f / 1024.0f) + 1e-6f);
#pragma unroll
        for (int j = 0; j < 4; ++j) {
            const f32x4 g4 = *(const f32x4*)(fg + j * 256 + lane * 4);
            *(f32x4*)(p.out + (size_t)r * DM + j * 256 + lane * 4) = v[j] * rstd * g4;
        }
    }
}

#define NPHASE 23
#ifndef DUP_S
#define DUP_S -1
#endif
#ifndef DUP_SUB
#define DUP_SUB 0
#endif
#ifdef XCC_REMAP
#define BID_SRC __builtin_amdgcn_readfirstlane(*(volatile int*)(lds + LDS_MISC + 976))
#else
#define BID_SRC blockIdx.x
#endif
#define LAUNDER() DP p; *(Params*)&p = p_in; int tid = threadIdx.x; { int bid_ = BID_SRC, nblk_ = gridDim.x; \
    asm volatile("" : "+v"(tid)); asm volatile("" : "+s"(p.ws)); asm volatile("" : "+s"(bid_)); asm volatile("" : "+s"(nblk_)); p.bid = bid_; p.nblk = nblk_; }
#define GBAR() { gchar* wsb_ = p_in.ws; asm volatile("" : "+s"(wsb_)); xcd_barrier((unsigned*)(wsb_ + OFF_BAR), st); }
#define REP(s_) _Pragma("unroll 1") for (int r_ = (DUP_S == (s_) ? 0 : 1); r_ < 2; ++r_)

#ifndef ONLY
#define ONLY -1
#endif
#ifndef FAKE
#define FAKE 0
#endif
#define ON(k) (ONLY < 0 || ONLY == (k))
#define RUN_LAYER(L) \
    if (L == 0) { if (ON(0)) { LAUNDER(); REP(0) { norm_pass(p, L, 0, tid); conv_weights(p, L, lds, tid); } } GBAR(); }     \
    if (ON(1)) { LAUNDER(); REP(1) phase_inproj(p, L, lds, tid, r_ == 0 ? FAKE : 0); } GBAR(); \
    if (ON(2)) { LAUNDER(); REP(2) phase_mla(p, L, lds, tid); } GBAR(); \
    if (ON(3)) { LAUNDER(); REP(3) phase_mixers(p, L, lds, tid, r_ == 0 ? DUP_SUB : 15); } GBAR(); \
    if (ON(4)) { LAUNDER(); REP(4) phase_combine(p, L, tid); } GBAR(); \
    if (ON(5)) { LAUNDER(); REP(5) phase_merge(p, L, lds, tid); phase_convq(p, L, lds, tid); } GBAR(); \
    if (ON(6)) { LAUNDER(); phase_wout(p, L, lds, tid); } GBAR(); \
    if (ON(7)) { LAUNDER(); REP(7) { norm_pass(p, L, 1, tid); } } GBAR(); \
    if (ON(8)) { LAUNDER(); REP(8) phase_peerq(p, L, lds, tid); if (L + 1 < DEPTH_ && CONVW_IN8) conv_weights(p, L + 1, lds, tid, 1); } GBAR();     \
    if (ON(9)) { LAUNDER(); if (DUP_S == 9) phase_peer<true>(p, L, lds, tid); phase_peer<false>(p, L, lds, tid); if (L + 1 < DEPTH_) { if (!CONVW_IN8) conv_weights(p, L + 1, lds, tid, 1); conv_weights(p, L + 1, lds, tid, 2); } } if (L != DEPTH_ - 1) GBAR();

__global__ void __launch_bounds__(NTHREADS, 2) fwd_kernel(Params p_in) {
    __shared__ __attribute__((aligned(16))) char lds[LDS_BYTES];
    volatile unsigned* st = (volatile unsigned*)(lds + LDS_MISC + 1008);
    if (threadIdx.x == 0) {
        st[0] = 0u; st[1] = 0u;
#ifdef XCC_REMAP
        const unsigned xcc = xb_xcc_id() & 7u;
        const unsigned rank = xb_add((unsigned*)(p_in.ws + OFF_BAR) + 3712 + 16 * xcc, 1u);
        *(volatile int*)(lds + LDS_MISC + 976) = (int)(rank * 8u + xcc);
#endif
    }
    __syncthreads();
    xcd_barrier_post((unsigned*)(p_in.ws + OFF_BAR));
    { LAUNDER(); phase_p0(p, lds, tid); } GBAR();
    { LAUNDER(); phase_p0b(p, tid); } GBAR();
    RUN_LAYER(0)
    RUN_LAYER(1)
}

extern "C" void kernel_launch(void* const* d_in, const int* in_sizes, int n_in, void* d_out, int out_size, void* d_ws, size_t ws_size, hipStream_t stream) {
    static int grid_blocks = 0;
    if (!grid_blocks) {
        int dev = 0, cus = 0, per_cu = 0;
        hipGetDevice(&dev);
        hipDeviceGetAttribute(&cus, hipDeviceAttributeMultiprocessorCount, dev);
        hipOccupancyMaxActiveBlocksPerMultiprocessor(&per_cu, fwd_kernel, NTHREADS, 0);
        if (per_cu > 2) per_cu = 2;
        if (per_cu < 1) per_cu = 1;
        grid_blocks = cus * per_cu;
        if (ws_size < OFF_TOP) fprintf(stderr, "workspace too small: %zu < %zu\n", ws_size, (size_t)OFF_TOP);
    }
    Params p{};
    for (int i = 0; i < 28; ++i) p.in[i] = (const float*)d_in[i];
    p.out = (float*)d_out;
    p.ws = (gchar*)d_ws;
#if MEGA
    hipMemsetAsync(d_ws, 0, 16384, stream);
    void* args[] = {&p};
    hipError_t e = hipLaunchCooperativeKernel((void*)fwd_kernel, dim3(grid_blocks), dim3(NTHREADS), args, 0, stream);
    if (e != hipSuccess) fprintf(stderr, "cooperative launch failed: %s (grid %d)\n", hipGetErrorString(e), grid_blocks);
#endif
}
```
